# Optimizing an MI355X kernel written in HIP

```python
import jax, jax.numpy as jnp
from jax import lax
import numpy as np

D_MODEL = 1024
BATCH = 2
SEQ = 8192
DEPTH = 4

GRID_W = 64
CTX_LEN = 256
N_MIXERS = 3
HEAD_DIM = 64
N_HEADS = D_MODEL // HEAD_DIM
A_KV_HEADS = 4
C_KV_HEADS = 2
Q_BLOCK = 128
WINDOW = 128
ROPE_THETA = 10000.0
RWKV_HEAD = 64
RWKV_HEADS = D_MODEL // RWKV_HEAD
DECAY_LORA = 64
ICLR_LORA = 64
GATE_LORA = 128
N_GROUPS = 4
EXPERTS_PER_GROUP = 8
N_EXPERTS = N_GROUPS * EXPERTS_PER_GROUP
TOP_K = 2
D_EXPERT = 768
MOE_BLOCK = 128
N_A_LAYERS = (DEPTH + 2) // 3
N_B_LAYERS = (DEPTH + 1) // 3
N_C_LAYERS = DEPTH // 3
NORM_EPS = 1e-6
LN_X_EPS = 64e-5
NEG_INF = -1e30

kernel_name = 'hybrid_dit_gqa_rwkv7_swa_hmoe'


def rms_norm(x, g):
    xf = x.astype(jnp.float32)
    y = xf * lax.rsqrt(jnp.mean(xf * xf, axis=-1, keepdims=True) + NORM_EPS)
    return (y * g.astype(jnp.float32)).astype(x.dtype)


def modulate(x, g, shift, scale):
    return rms_norm(x, g) * (1 + scale) + shift


def axial_rope_tables(rows):
    row = jnp.repeat(jnp.arange(rows, dtype=jnp.float32), GRID_W)
    col = jnp.tile(jnp.arange(GRID_W, dtype=jnp.float32), rows)
    axis_dim = HEAD_DIM // 2
    inv_freq = ROPE_THETA ** (-jnp.arange(0, axis_dim, 2, dtype=jnp.float32) / axis_dim)
    a_row = row[:, None] * inv_freq
    a_col = col[:, None] * inv_freq
    ang = jnp.concatenate([a_row, a_row, a_col, a_col], axis=-1)[:, None, :]
    return jnp.cos(ang), jnp.sin(ang)


def apply_rope(x, cos, sin):
    xr = x.reshape(*x.shape[:-1], 2, 2, HEAD_DIM // 4)
    rot = jnp.concatenate([-xr[..., 1:, :], xr[..., :1, :]], axis=-2).reshape(x.shape)
    return x * cos.astype(x.dtype) + rot * sin.astype(x.dtype)


def split_qkv(qkv, n_kv):
    b, s, _ = qkv.shape
    qd, kd = N_HEADS * HEAD_DIM, n_kv * HEAD_DIM
    q = qkv[..., :qd].reshape(b, s, N_HEADS, HEAD_DIM)
    k = qkv[..., qd:qd + kd].reshape(b, s, n_kv, HEAD_DIM)
    v = qkv[..., qd + kd:].reshape(b, s, n_kv, HEAD_DIM)
    return q, k, v


def attend(q, keys, values, mask=None, sink=None):
    s = jnp.einsum('bqhgd,bkhd->bhgqk', q, keys).astype(jnp.float32) * (HEAD_DIM ** -0.5)
    if mask is not None:
        s = jnp.where(mask, s, NEG_INF)
    if sink is not None:
        sink_col = jnp.broadcast_to(sink.astype(jnp.float32)[None, :, :, None, None], s.shape[:-1] + (1,))
        p = jax.nn.softmax(jnp.concatenate([s, sink_col], axis=-1), axis=-1)[..., :-1]
    else:
        p = jax.nn.softmax(s, axis=-1)
    return jnp.einsum('bhgqk,bkhd->bqhgd', p.astype(values.dtype), values)


def dense_gqa_mixer(h_lat, h_ctx, w_qkv, w_o, q_gain, k_gain, cos, sin, with_ctx_out):
    b, s, _ = h_lat.shape
    n_ctx = h_ctx.shape[1]
    grp = N_HEADS // A_KV_HEADS
    q_l, k_l, v_l = split_qkv(h_lat @ w_qkv, A_KV_HEADS)
    q_c, k_c, v_c = split_qkv(h_ctx @ w_qkv, A_KV_HEADS)
    q_l = apply_rope(rms_norm(q_l, q_gain), cos, sin)
    k_l = apply_rope(rms_norm(k_l, k_gain), cos, sin)
    q_c, k_c = rms_norm(q_c, q_gain), rms_norm(k_c, k_gain)
    k_all = jnp.concatenate([k_c, k_l], axis=1)
    v_all = jnp.concatenate([v_c, v_l], axis=1)
    q_blocks = q_l.reshape(b, s // Q_BLOCK, Q_BLOCK, A_KV_HEADS, grp, HEAD_DIM).transpose(1, 0, 2, 3, 4, 5)
    o_l = lax.map(lambda qb: attend(qb, k_all, v_all), q_blocks)
    y_l = o_l.transpose(1, 0, 2, 3, 4, 5).reshape(b, s, D_MODEL) @ w_o
    y_c = None
    if with_ctx_out:
        o_c = attend(q_c.reshape(b, n_ctx, A_KV_HEADS, grp, HEAD_DIM), k_c, v_c)
        y_c = o_c.reshape(b, n_ctx, D_MODEL) @ w_o
    return y_l, y_c


def window_gqa_mixer(h_lat, h_ctx, w_qkv, w_o, sink, cos, sin, with_ctx_out):
    b, s, _ = h_lat.shape
    n_ctx = h_ctx.shape[1]
    grp = N_HEADS // C_KV_HEADS
    span = Q_BLOCK + 2 * WINDOW
    q_l, k_l, v_l = split_qkv(h_lat @ w_qkv, C_KV_HEADS)
    q_c, k_c, v_c = split_qkv(h_ctx @ w_qkv, C_KV_HEADS)
    q_l = apply_rope(q_l, cos, sin).reshape(b, s, C_KV_HEADS, grp, HEAD_DIM)
    k_l = apply_rope(k_l, cos, sin)
    pad = ((0, 0), (WINDOW, WINDOW), (0, 0), (0, 0))
    k_pad, v_pad = jnp.pad(k_l, pad), jnp.pad(v_l, pad)
    sink = sink.reshape(C_KV_HEADS, grp)
    ctx_mask = jnp.ones((Q_BLOCK, n_ctx), dtype=bool)

    def band_block(blk):
        start = blk * Q_BLOCK
        qb = lax.dynamic_slice_in_dim(q_l, start, Q_BLOCK, axis=1)
        kb = lax.dynamic_slice_in_dim(k_pad, start, span, axis=1)
        vb = lax.dynamic_slice_in_dim(v_pad, start, span, axis=1)
        q_pos = start + jnp.arange(Q_BLOCK)
        k_pos = start - WINDOW + jnp.arange(span)
        band = (jnp.abs(q_pos[:, None] - k_pos[None, :]) <= WINDOW) & (k_pos >= 0)[None, :] & (k_pos < s)[None, :]
        keys = jnp.concatenate([k_c, kb], axis=1)
        vals = jnp.concatenate([v_c, vb], axis=1)
        return attend(qb, keys, vals, jnp.concatenate([ctx_mask, band], axis=1), sink)

    o_l = lax.map(band_block, jnp.arange(s // Q_BLOCK))
    y_l = o_l.transpose(1, 0, 2, 3, 4, 5).reshape(b, s, D_MODEL) @ w_o
    y_c = None
    if with_ctx_out:
        o_c = attend(q_c.reshape(b, n_ctx, C_KV_HEADS, grp, HEAD_DIM), k_c, v_c, sink=sink)
        y_c = o_c.reshape(b, n_ctx, D_MODEL) @ w_o
    return y_l, y_c


def token_shift_centred(x):
    prev = jnp.pad(x[:, :-1], ((0, 0), (1, 0), (0, 0)))
    nxt = jnp.pad(x[:, 1:], ((0, 0), (0, 1), (0, 0)))
    return 0.5 * (prev + nxt)


def rwkv_heads(t):
    return t.reshape(*t.shape[:-1], RWKV_HEADS, RWKV_HEAD)


def rwkv7_features(h, mu, w_r, w_k, w_v, w0, w1, w2, a0, a1, a2, g1, g2, k_k, k_a):
    xx = token_shift_centred(h) - h
    xr, xw, xk, xv, xa, xg = [h + xx * mu[i] for i in range(6)]
    r, k, v = xr @ w_r, xk @ w_k, xv @ w_v
    g = jax.nn.sigmoid(xg @ g1) @ g2
    w_log = w0[:, None, None, :] + jnp.einsum('nbsr,nrd->nbsd', jnp.tanh(jnp.einsum('bsd,ndr->nbsr', xw, w1)), w2)
    decay = jnp.exp(-jnp.exp(-jax.nn.softplus(-w_log.astype(jnp.float32)) - 0.5))
    iclr = jax.nn.sigmoid((a0[:, None, None, :] + jnp.einsum('nbsr,nrd->nbsd', jnp.einsum('bsd,ndr->nbsr', xa, a1), a2)).astype(jnp.float32))
    kk = rwkv_heads((k * k_k).astype(jnp.float32))
    kk = (kk / jnp.maximum(jnp.linalg.norm(kk, axis=-1, keepdims=True), 1e-12)).reshape(k.shape)
    k_dir = k[None].astype(jnp.float32) * (1 + (iclr - 1) * k_a.astype(jnp.float32))
    return r, v, g, decay, iclr, kk, k_dir


def rwkv7_scan(state0, r, decay, k, v, kk, iclr, reverse):
    xs = tuple(jnp.moveaxis(rwkv_heads(t.astype(jnp.float32)), 1, 0) for t in (r, decay, k, v, kk, iclr))

    def step(st, inp):
        r_t, w_t, k_t, v_t, kk_t, a_t = inp
        sa = jnp.einsum('bhvk,bhk->bhv', st, -kk_t)
        st = st * w_t[:, :, None, :] + sa[..., None] * (kk_t * a_t)[:, :, None, :] + v_t[..., None] * k_t[:, :, None, :]
        return st, jnp.einsum('bhvk,bhk->bhv', st, r_t)

    s_final, ys = lax.scan(step, state0, xs, reverse=reverse)
    y = jnp.moveaxis(ys, 0, 1)
    return s_final, y.reshape(*y.shape[:2], D_MODEL)


def rwkv7_bidir(feats, state_fwd, state_bwd):
    r, v, _, decay, iclr, kk, k_dir = feats
    s_f, y_f = rwkv7_scan(state_fwd, r, decay[0], k_dir[0], v, kk, iclr[0], reverse=False)
    s_b, y_b = rwkv7_scan(state_bwd, r, decay[1], k_dir[1], v, kk, iclr[1], reverse=True)
    return s_f, s_b, y_f + y_b


def rwkv7_output(y, feats, r_k, ln_w, ln_b, w_o):
    r, v, g, _, _, _, k_dir = feats
    yh = rwkv_heads(y)
    mean = jnp.mean(yh, axis=-1, keepdims=True)
    var = jnp.mean(jnp.square(yh - mean), axis=-1, keepdims=True)
    yn = ((yh - mean) * lax.rsqrt(var + LN_X_EPS)).reshape(y.shape) * ln_w + ln_b
    bonus = jnp.sum(rwkv_heads(r.astype(jnp.float32) * (k_dir[0] + k_dir[1])) * r_k, axis=-1, keepdims=True) * rwkv_heads(v.astype(jnp.float32))
    out = (yn + bonus.reshape(y.shape)).astype(g.dtype) * g
    return out @ w_o


def rwkv7_mixer(h_lat, h_ctx, p, with_ctx_out):
    (mu, w_r, w_k, w_v, w_o, w0, w1, w2, a0, a1, a2, g1, g2, k_k, k_a, r_k, ln_w, ln_b) = p
    f_c = rwkv7_features(h_ctx, mu, w_r, w_k, w_v, w0, w1, w2, a0, a1, a2, g1, g2, k_k, k_a)
    f_l = rwkv7_features(h_lat, mu, w_r, w_k, w_v, w0, w1, w2, a0, a1, a2, g1, g2, k_k, k_a)
    zero = jnp.zeros((h_lat.shape[0], RWKV_HEADS, RWKV_HEAD, RWKV_HEAD), jnp.float32)
    s_f, s_b, y_c = rwkv7_bidir(f_c, zero, zero)
    _, _, y_l = rwkv7_bidir(f_l, s_f, s_b)
    y_lat = rwkv7_output(y_l, f_l, r_k, ln_w, ln_b, w_o).astype(h_lat.dtype)
    y_ctx = rwkv7_output(y_c, f_c, r_k, ln_w, ln_b, w_o).astype(h_ctx.dtype) if with_ctx_out else None
    return y_lat, y_ctx


def hier_moe(h, w_group, b_group, w_expert, b_expert, w1, w3, w2):
    n_tok, d = h.shape
    g_logit = (h @ w_group).astype(jnp.float32) + b_group.astype(jnp.float32)
    g_idx = jnp.argmax(g_logit, axis=-1)
    g_w = jnp.take_along_axis(jax.nn.softmax(g_logit, axis=-1), g_idx[:, None], axis=-1)
    e_logit = ((h @ w_expert).astype(jnp.float32) + b_expert.astype(jnp.float32)).reshape(n_tok, N_GROUPS, EXPERTS_PER_GROUP)
    e_logit = jnp.take_along_axis(e_logit, g_idx[:, None, None], axis=1)[:, 0]
    top_p, top_i = lax.top_k(jax.nn.softmax(e_logit, axis=-1), TOP_K)
    weight = (g_w * top_p / jnp.sum(top_p, axis=-1, keepdims=True)).reshape(-1)
    expert = (g_idx[:, None] * EXPERTS_PER_GROUP + top_i).reshape(-1)
    token = jnp.repeat(jnp.arange(n_tok, dtype=jnp.int32), TOP_K)
    n_assign = n_tok * TOP_K
    n_blocks = -(-n_assign // MOE_BLOCK) + N_EXPERTS
    order = jnp.argsort(expert)
    e_sorted = expert[order]
    counts = jax.ops.segment_sum(jnp.ones_like(expert), expert, num_segments=N_EXPERTS)
    start = jnp.cumsum(counts) - counts
    padded = (counts + MOE_BLOCK - 1) // MOE_BLOCK * MOE_BLOCK
    p_end = jnp.cumsum(padded)
    dest = (p_end - padded)[e_sorted] + jnp.arange(n_assign) - start[e_sorted]
    tok_pad = jnp.full((n_blocks * MOE_BLOCK,), n_tok, jnp.int32).at[dest].set(token[order])
    w_pad = jnp.zeros((n_blocks * MOE_BLOCK,), jnp.float32).at[dest].set(weight[order])
    blk_expert = jnp.minimum(jnp.searchsorted(p_end, jnp.arange(n_blocks) * MOE_BLOCK, side='right'), N_EXPERTS - 1)
    h_pad = jnp.concatenate([h, jnp.zeros((1, d), h.dtype)], axis=0)

    def expert_block(args):
        tok_b, w_b, e = args
        xb = h_pad[tok_b]
        hid = jax.nn.silu(xb @ w1[e]) * (xb @ w3[e])
        return (hid @ w2[e]) * w_b[:, None].astype(h.dtype)

    ys = lax.map(expert_block, (tok_pad.reshape(n_blocks, MOE_BLOCK), w_pad.reshape(n_blocks, MOE_BLOCK), blk_expert))
    out = jnp.zeros_like(h_pad).at[tok_pad].add(ys.reshape(-1, d))
    return out[:n_tok]


def setup_inputs(seed: int = 0) -> dict:
    key = jax.random.key(seed)
    ks = iter(jax.random.split(key, 64))

    def nrm(shape, scale):
        return jax.random.normal(next(ks), shape, jnp.float32) * scale

    def gain(shape):
        return 1.0 + nrm(shape, 0.05)

    d = D_MODEL
    qkv_a = (N_HEADS + 2 * A_KV_HEADS) * HEAD_DIM
    qkv_c = (N_HEADS + 2 * C_KV_HEADS) * HEAD_DIM
    decay_ramp = jnp.linspace(-6.5, -1.5, d, dtype=jnp.float32)
    return {
        'x': nrm((BATCH, SEQ, d), 1.0),
        'c': nrm((BATCH, d), 1.0),
        'ctx': nrm((BATCH, CTX_LEN, d), 1.0),
        'c_ctx': nrm((d,), 1.0),
        'mod_w': nrm((DEPTH, d, 6 * d), 0.5 * d ** -0.5),
        'mod_b': nrm((DEPTH, 6 * d), 0.02),
        'norm1_g': gain((DEPTH, d)),
        'norm2_g': gain((DEPTH, d)),
        'a_w_qkv': nrm((N_A_LAYERS, d, qkv_a), d ** -0.5),
        'a_w_o': nrm((N_A_LAYERS, d, d), d ** -0.5),
        'a_q_gain': gain((N_A_LAYERS, HEAD_DIM)),
        'a_k_gain': gain((N_A_LAYERS, HEAD_DIM)),
        'b_mu': jax.random.uniform(next(ks), (N_B_LAYERS, 6, d), jnp.float32),
        'b_w_r': nrm((N_B_LAYERS, d, d), d ** -0.5),
        'b_w_k': nrm((N_B_LAYERS, d, d), d ** -0.5),
        'b_w_v': nrm((N_B_LAYERS, d, d), d ** -0.5),
        'b_w_o': nrm((N_B_LAYERS, d, d), d ** -0.5),
        'b_decay_w0': decay_ramp + nrm((N_B_LAYERS, 2, d), 0.1),
        'b_decay_w1': nrm((N_B_LAYERS, 2, d, DECAY_LORA), 0.5 * d ** -0.5),
        'b_decay_w2': nrm((N_B_LAYERS, 2, DECAY_LORA, d), 0.5 * DECAY_LORA ** -0.5),
        'b_iclr_a0': nrm((N_B_LAYERS, 2, d), 0.3),
        'b_iclr_a1': nrm((N_B_LAYERS, 2, d, ICLR_LORA), d ** -0.5),
        'b_iclr_a2': nrm((N_B_LAYERS, 2, ICLR_LORA, d), 0.5 * ICLR_LORA ** -0.5),
        'b_gate_g1': nrm((N_B_LAYERS, d, GATE_LORA), d ** -0.5),
        'b_gate_g2': nrm((N_B_LAYERS, GATE_LORA, d), GATE_LORA ** -0.5),
        'b_k_k': 0.85 + nrm((N_B_LAYERS, d), 0.05),
        'b_k_a': gain((N_B_LAYERS, d)),
        'b_r_k': nrm((N_B_LAYERS, RWKV_HEADS, RWKV_HEAD), 0.1),
        'b_ln_w': gain((N_B_LAYERS, d)),
        'b_ln_b': nrm((N_B_LAYERS, d), 0.02),
        'c_w_qkv': nrm((N_C_LAYERS, d, qkv_c), d ** -0.5),
        'c_w_o': nrm((N_C_LAYERS, d, d), d ** -0.5),
        'c_sink': nrm((N_C_LAYERS, N_HEADS), 0.5),
        'moe_w_group': nrm((DEPTH, d, N_GROUPS), d ** -0.5),
        'moe_b_group': nrm((DEPTH, N_GROUPS), 0.01),
        'moe_w_expert': nrm((DEPTH, d, N_EXPERTS), d ** -0.5),
        'moe_b_expert': nrm((DEPTH, N_EXPERTS), 0.01),
        'moe_w1': nrm((DEPTH, N_EXPERTS, d, D_EXPERT), d ** -0.5),
        'moe_w3': nrm((DEPTH, N_EXPERTS, d, D_EXPERT), d ** -0.5),
        'moe_w2': nrm((DEPTH, N_EXPERTS, D_EXPERT, d), D_EXPERT ** -0.5),
        'final_g': gain((d,)),
    }


def reference(x, c, ctx, c_ctx, mod_w, mod_b, norm1_g, norm2_g, a_w_qkv, a_w_o, a_q_gain, a_k_gain,
              b_mu, b_w_r, b_w_k, b_w_v, b_w_o, b_decay_w0, b_decay_w1, b_decay_w2, b_iclr_a0, b_iclr_a1,
              b_iclr_a2, b_gate_g1, b_gate_g2, b_k_k, b_k_a, b_r_k, b_ln_w, b_ln_b, c_w_qkv, c_w_o, c_sink,
              moe_w_group, moe_b_group, moe_w_expert, moe_b_expert, moe_w1, moe_w3, moe_w2, final_g):
    b, s, d = x.shape
    n_ctx = ctx.shape[1]
    rows = s // GRID_W
    cos, sin = axial_rope_tables(rows)
    cond_lat = jax.nn.silu(c)
    cond_ctx = jax.nn.silu(c_ctx)
    x_lat, x_ctx = x, ctx
    for l in range(DEPTH):
        last = l == DEPTH - 1
        m_lat = jnp.split((cond_lat @ mod_w[l] + mod_b[l])[:, None, :], 6, axis=-1)
        m_ctx = jnp.split(cond_ctx @ mod_w[l] + mod_b[l], 6, axis=-1)
        h_lat = modulate(x_lat, norm1_g[l], m_lat[0], m_lat[1])
        h_ctx = modulate(x_ctx, norm1_g[l], m_ctx[0], m_ctx[1])
        kind, j = l % N_MIXERS, l // N_MIXERS
        if kind == 0:
            y_lat, y_ctx = dense_gqa_mixer(h_lat, h_ctx, a_w_qkv[j], a_w_o[j], a_q_gain[j], a_k_gain[j], cos, sin, not last)
        elif kind == 1:
            params = (b_mu[j], b_w_r[j], b_w_k[j], b_w_v[j], b_w_o[j], b_decay_w0[j], b_decay_w1[j], b_decay_w2[j],
                      b_iclr_a0[j], b_iclr_a1[j], b_iclr_a2[j], b_gate_g1[j], b_gate_g2[j], b_k_k[j], b_k_a[j],
                      b_r_k[j], b_ln_w[j], b_ln_b[j])
            y_lat, y_ctx = rwkv7_mixer(h_lat, h_ctx, params, not last)
        else:
            y_lat, y_ctx = window_gqa_mixer(h_lat, h_ctx, c_w_qkv[j], c_w_o[j], c_sink[j], cos, sin, not last)
        x_lat = x_lat + m_lat[2] * y_lat
        h2_lat = modulate(x_lat, norm2_g[l], m_lat[3], m_lat[4])
        moe_p = (moe_w_group[l], moe_b_group[l], moe_w_expert[l], moe_b_expert[l], moe_w1[l], moe_w3[l], moe_w2[l])
        if last:
            f_lat = hier_moe(h2_lat.reshape(-1, d), *moe_p).reshape(b, s, d)
            x_lat = x_lat + m_lat[5] * f_lat
        else:
            x_ctx = x_ctx + m_ctx[2] * y_ctx
            h2_ctx = modulate(x_ctx, norm2_g[l], m_ctx[3], m_ctx[4])
            f_all = hier_moe(jnp.concatenate([h2_ctx.reshape(-1, d), h2_lat.reshape(-1, d)], axis=0), *moe_p)
            x_ctx = x_ctx + m_ctx[5] * f_all[:b * n_ctx].reshape(b, n_ctx, d)
            x_lat = x_lat + m_lat[5] * f_all[b * n_ctx:].reshape(b, s, d)
    return rms_norm(x_lat, final_g)
```

```cpp
#include <hip/hip_runtime.h>
#include <cstdio>
#include <cstdint>

#define DI __device__ __forceinline__
#define LAS __attribute__((address_space(3)))
typedef unsigned short bf16_t;
typedef short bf16x8 __attribute__((ext_vector_type(8)));
typedef short s16x4 __attribute__((ext_vector_type(4)));
typedef float f32x2 __attribute__((ext_vector_type(2)));
typedef float f32x4 __attribute__((ext_vector_type(4)));
typedef float f32x16 __attribute__((ext_vector_type(16)));
typedef unsigned u32x2 __attribute__((ext_vector_type(2)));
typedef unsigned u32x4 __attribute__((ext_vector_type(4)));
typedef _Float16 h16;
typedef _Float16 h16x8 __attribute__((ext_vector_type(8)));
typedef _Float16 h16x4 __attribute__((ext_vector_type(4)));
typedef __bf16 bf16x2_t __attribute__((ext_vector_type(2)));

constexpr int DM = 1024, NB = 2, SEQ = 8192, NCTX = 256, NCTXR = NB * NCTX, MROWS = NCTXR + NB * SEQ, KVLEN = NCTX + SEQ;
constexpr int NEXP = 32, DEXP = 768, MOE_MAXBLK = 164, MOE_ROWS = MOE_MAXBLK * 256;
constexpr int DEPTH = 4;
constexpr float NORM_EPS = 1e-6f, LN_X_EPS = 64e-5f;
constexpr float C2 = 0.125f * 1.4426950408889634f;
constexpr float LOG2E = 1.4426950408889634f;

enum { I_X = 0, I_C, I_CTX, I_CCTX, I_MODW, I_MODB, I_N1G, I_N2G, I_AQKV, I_AO, I_AQG, I_AKG, I_BMU, I_BWR, I_BWK, I_BWV, I_BWO, I_BW0, I_BW1, I_BW2,
       I_BA0, I_BA1, I_BA2, I_BG1, I_BG2, I_BKK, I_BKA, I_BRK, I_BLNW, I_BLNB, I_CQKV, I_CO, I_CSINK, I_MWG, I_MBG, I_MWE, I_MBE, I_MW1, I_MW3, I_MW2, I_FG, N_IN };

constexpr size_t MiB = 1ull << 20;
constexpr size_t WS_CTL = 0, CTL_ZERO_BYTES = 1 * MiB;
constexpr size_t WS_MOD = 1 * MiB;
constexpr size_t WS_ROPE = WS_MOD + 512 * 1024;
constexpr size_t WS_WR = 2 * MiB;
constexpr size_t WS_TOK = 3 * MiB;
constexpr size_t TOK_STRIDE = (size_t)MROWS * 8;
constexpr size_t WS_ROWTOK = WS_TOK + 4 * TOK_STRIDE;
constexpr size_t WS_BONUS = 4 * MiB;
constexpr size_t WS_WAQKV = 6 * MiB;
constexpr size_t WS_WAO = 12 * MiB;
constexpr size_t WS_WCQKV = 16 * MiB;
constexpr size_t WS_WCO = 19 * MiB;
constexpr size_t WS_WBRKVL = 21 * MiB;
constexpr size_t WS_WBO = 29 * MiB;
constexpr size_t WS_WBL2 = 31 * MiB;
constexpr size_t WS_WM13 = 34 * MiB;
constexpr size_t WS_WM2 = 418 * MiB;
constexpr size_t WS_XRES = 610 * MiB;
constexpr size_t WS_HA0 = 676 * MiB;
constexpr size_t WS_A = 709 * MiB;
constexpr size_t WS_B = 907 * MiB;
constexpr size_t WS_C = 1023 * MiB;
constexpr size_t WS_XRES2 = 1353 * MiB;
constexpr size_t WS_PART = 1419 * MiB;
constexpr size_t WS_BONUS2 = 1435 * MiB;
constexpr size_t WS_LIST = 1438 * MiB;
constexpr size_t WS_END = 1441 * MiB;
constexpr size_t ROWB = (size_t)MROWS * DM;
constexpr size_t WS_MIX = WS_A;
constexpr size_t WS_EA16 = WS_A;
constexpr size_t WS_G = WS_A + 132 * MiB;
constexpr size_t WS_YS = WS_C;
constexpr size_t WS_Q = WS_A;
constexpr size_t WS_O = WS_A + 33 * MiB;
constexpr size_t WS_K = WS_A + 66 * MiB;
constexpr size_t WS_V = WS_A + 75 * MiB;
constexpr size_t WS_RKV16 = WS_B;
constexpr size_t WS_TWA = WS_B + 99 * MiB;
constexpr size_t WS_TG = WS_B + 99 * MiB + (size_t)MROWS * 256 * 2;
constexpr size_t WS_SC = WS_C;
constexpr size_t WS_ASORT = WS_C;
constexpr size_t WS_HID = WS_C + 82 * MiB;
constexpr size_t WS_YASG = WS_C + 144 * MiB;
static_assert(WS_TG + (size_t)MROWS * 256 * 2 <= WS_C && WS_YASG + (size_t)MOE_ROWS * 1024 * 2 <= WS_END && (size_t)64 * KVLEN * 640 <= 330 * MiB, "ws map");
static_assert(WS_WM13 + (size_t)128 * 1536 * 1024 * 2 <= WS_WM2 && WS_WM2 + (size_t)128 * 1024 * 768 * 2 <= WS_XRES, "ws map 2");
constexpr int CW_BAR = 4096;
constexpr int CW_CNT = 16384;

constexpr int LDS_MISC = 147456;
constexpr int LDS_BYTES = LDS_MISC + 4096;
constexpr int MISC_BAR = 0, MISC_START = 64, MISC_BLKE = 256, MISC_PTAB = 1024, MISC_CNTL = 1536;

DI size_t xres_of(int l) { return l == 1 ? WS_XRES2 : WS_XRES; }
struct Params { const float* in[N_IN]; float* out; unsigned char* ws; };
struct Ctx { const volatile LAS unsigned long long* tab; unsigned char* ws; float* out;
    __device__ __forceinline__ const float* in(int i) const { const unsigned long long v = tab[i];
        const unsigned lo = __builtin_amdgcn_readfirstlane((unsigned)v), hi = __builtin_amdgcn_readfirstlane((unsigned)(v >> 32)); return (const float*)(((unsigned long long)hi << 32) | lo); } };

DI unsigned cvt_pk_bf16(float lo, float hi) { f32x2 v = {lo, hi}; bf16x2_t b = __builtin_convertvector(v, bf16x2_t); return __builtin_bit_cast(unsigned, b); }
DI float bf_lo(unsigned u) { return __builtin_bit_cast(float, u << 16); }
DI float bf_hi(unsigned u) { return __builtin_bit_cast(float, u & 0xffff0000u); }
DI float wave_sum(float v) {
#pragma unroll
    for (int o = 1; o < 64; o <<= 1) v += __shfl_xor(v, o);
    return v;
}
template <int CTRL> DI float dpp_add(float x) { const int xi = __builtin_bit_cast(int, x); const int yi = __builtin_amdgcn_update_dpp(0, xi, CTRL, 0xF, 0xF, true); return x + __builtin_bit_cast(float, yi); }
DI float allreduce16(float x) { x = dpp_add<0xB1>(x); x = dpp_add<0x4E>(x); x = dpp_add<0x141>(x); x = dpp_add<0x140>(x); return x; }
template <int CTRL> DI float dpp_mov(float x) { return __builtin_bit_cast(float, __builtin_amdgcn_update_dpp(0, __builtin_bit_cast(int, x), CTRL, 0xF, 0xF, true)); }
DI float merge4_reduce16(float a, float b, float c, float d, int lane) {
    const bool b0 = (lane & 1) != 0, b1 = (lane & 2) != 0;
    const float x = (b0 ? b : a) + dpp_mov<0xB1>(b0 ? a : b);
    const float z = (b0 ? d : c) + dpp_mov<0xB1>(b0 ? c : d);
    float w = (b1 ? z : x) + dpp_mov<0x4E>(b1 ? x : z);
    w += dpp_mov<0x124>(w); w += dpp_mov<0x128>(w);
    return w;
}
DI float wave_sum_dpp(float x) { x = allreduce16(x);
    const float a = __builtin_bit_cast(float, __builtin_amdgcn_readlane(__builtin_bit_cast(int, x), 0)), b = __builtin_bit_cast(float, __builtin_amdgcn_readlane(__builtin_bit_cast(int, x), 16)),
                c = __builtin_bit_cast(float, __builtin_amdgcn_readlane(__builtin_bit_cast(int, x), 32)), d = __builtin_bit_cast(float, __builtin_amdgcn_readlane(__builtin_bit_cast(int, x), 48));
    return (a + b) + (c + d); }
DI int vec_of_row(int row) { return row < NCTXR ? 2 : ((row - NCTXR) >> 13); }
DI int kvrow_of(int row) { if (row < NCTXR) return (row >> 8) * KVLEN + (row & 255); const int r = row - NCTXR; return (r >> 13) * KVLEN + NCTX + (r & 8191); }
DI float silu_f(float x) { return x * __builtin_amdgcn_rcpf(1.f + __expf(-x)); }
DI float sigmoid_f(float x) { return __builtin_amdgcn_rcpf(1.f + __expf(-x)); }

#define XB_TMO      128
#define XB_XCNT(j)  (256  + 64 * (j))
#define XB_XSUB(j)  (1280 + 64 * (j))
#define XB_XGEN(j)  (2304 + 64 * (j))
#define XB_TOP      3328
#define XB_TOPGEN   3392
#define XCD_BAR_WORDS 3456
#define XB_SPIN_CAP (1u << 20)
DI unsigned xb_ld(unsigned* p)              { return __hip_atomic_load(p, __ATOMIC_RELAXED, __HIP_MEMORY_SCOPE_AGENT); }
DI unsigned xb_add(unsigned* p, unsigned v) { return __hip_atomic_fetch_add(p, v, __ATOMIC_RELAXED, __HIP_MEMORY_SCOPE_AGENT); }
DI unsigned xb_xcc_id() { return (unsigned)__builtin_amdgcn_s_getreg((3 << 11) | 20) & 0xFu; }
#define XB_SPIN(cond, bar) do { unsigned _sp = 0; while (cond) { __builtin_amdgcn_s_sleep(1); \
    if ((++_sp & 255u) == 0u) { if (xb_ld(&(bar)[XB_TMO])) break; if (_sp > XB_SPIN_CAP) { atomicAdd(&(bar)[XB_TMO], 1u); break; } } } } while (0)
struct XcdBarrier { unsigned* bar; unsigned x; volatile LAS unsigned* st; };
DI XcdBarrier xcd_barrier_post(unsigned* bar, volatile LAS unsigned* st) {
    XcdBarrier b; b.bar = bar; b.x = xb_xcc_id(); b.st = st;
    if (threadIdx.x == 0) (void)xb_add(&bar[XB_XCNT(b.x)], 1u);
    return b;
}
DI void xcd_barrier_complete(unsigned* bar, unsigned x, unsigned& nloc, unsigned& nx) {
    const unsigned G = gridDim.x * gridDim.y * gridDim.z;
    unsigned sum, cnt, mine, sp = 0u;
    for (;;) {
        sum = 0u; cnt = 0u; mine = 0u;
#pragma unroll
        for (unsigned j = 0; j < 16; ++j) { const unsigned c = xb_ld(&bar[XB_XCNT(j)]); sum += c; cnt += (c > 0u) ? 1u : 0u; mine = (j == x) ? c : mine; }
        if (sum == G) break;
        __builtin_amdgcn_s_sleep(1);
        if ((++sp & 255u) == 0u) { if (xb_ld(&bar[XB_TMO])) break; if (sp > XB_SPIN_CAP) { atomicAdd(&bar[XB_TMO], 1u); break; } }
    }
    nloc = mine > 0u ? mine : 1u; nx = cnt > 0u ? cnt : 1u;
}
__device__ __attribute__((noinline)) void xcd_barrier_fn(unsigned* bar_, unsigned x_, volatile LAS unsigned* st_, int tid_) {
    XcdBarrier b; b.bar = bar_; b.x = x_; b.st = st_;
    asm volatile("s_waitcnt vmcnt(0)" ::: "memory");
    __syncthreads();
    if (tid_ == 0) {
        unsigned* bar = b.bar;
        __builtin_amdgcn_s_waitcnt(0);
        unsigned nloc = b.st[0], nx = b.st[1];
        if (nloc == 0u) { xcd_barrier_complete(bar, b.x, nloc, nx); b.st[0] = nloc; b.st[1] = nx; }
        const unsigned old = xb_add(&bar[XB_XSUB(b.x)], 1u);
        const unsigned gen = old / nloc;
        if (old + 1u == (gen + 1u) * nloc) {
            __builtin_amdgcn_fence(__ATOMIC_RELEASE, "agent");
            asm volatile("s_waitcnt vmcnt(0)" ::: "memory");
            const unsigned og = xb_add(&bar[XB_TOP], 1u);
            const unsigned tg = og / nx;
            if (og + 1u == (tg + 1u) * nx) xb_add(&bar[XB_TOPGEN], 1u);
            else XB_SPIN(xb_ld(&bar[XB_TOPGEN]) == tg, bar);
            __builtin_amdgcn_fence(__ATOMIC_ACQUIRE, "agent");
            xb_add(&bar[XB_XGEN(b.x)], 1u);
            asm volatile("s_waitcnt vmcnt(0)" ::: "memory");
        } else {
            XB_SPIN(xb_ld(&bar[XB_XGEN(b.x)]) == gen, bar);
            __builtin_amdgcn_fence(__ATOMIC_ACQUIRE, "agent");
            asm volatile("s_waitcnt vmcnt(0)" ::: "memory");
        }
    }
    __syncthreads();
}

namespace pg8 {
constexpr int BM = 256, BK = 64, HALF = 128, HTB = HALF * BK * 2;
DI int lds_byte(int r, int c) { const int st = (r >> 4) * 2 + (c >> 5), rr = r & 15, cc = c & 31, ob = rr * 64 + cc * 2; return st * 1024 + (ob ^ (((ob >> 9) & 1) << 5)); }
DI void stage_rc(int b, int& R, int& C) { const int st = b / 1024, sb = b % 1024, swz = sb ^ (((sb >> 9) & 1) << 5); R = (st >> 1) * 16 + swz / 64; C = (st & 1) * 32 + (swz % 64) / 2; }
DI int perm32(int rho) { const int n = rho >> 4, i = rho & 15; return 8 * (i >> 2) + 4 * n + (i & 3); }
struct Unit { int pm, pn; const char* A; const char* B; int tok; };

template <class Epi, class Sched>
DI void gemm_phase(LAS unsigned char* lds, const int K, const Sched& S, const Epi& E, const int tid, const int ld_ = 0) {
    const int ld = ld_ ? ld_ : K;
    const int wid = __builtin_amdgcn_readfirstlane(tid >> 6), lane = tid & 63, wr = wid >> 2, wc = wid & 3, fr = lane & 15, fq = lane >> 4;
    const int nt = K / BK;
    unsigned voffA[2], voffB[2];
#pragma unroll
    for (int i = 0; i < 2; ++i) { int R, C; stage_rc(tid * 16 + i * 8192, R, C); const int Rb = Epi::PERM ? ((R & ~31) + perm32(R & 31)) : R;
        voffA[i] = (unsigned)(R * ld + C) * 2u; voffB[i] = (unsigned)(Rb * ld + C) * 2u; }
    constexpr bool GA = Sched::GATHER;
    unsigned oA[2][2], nO[2][2]; int gR[2], gC2[2];
#pragma unroll
    for (int i = 0; i < 2; ++i) { int R, C; stage_rc(tid * 16 + i * 8192, R, C); gR[i] = R; gC2[i] = C * 2; oA[0][i] = oA[1][i] = nO[0][i] = nO[1][i] = 0u; }
#define PG8_TOKOFF(dst, u) do { _Pragma("unroll") for (int _h = 0; _h < 2; ++_h) _Pragma("unroll") for (int _i = 0; _i < 2; ++_i) dst[_h][_i] = (unsigned)S.tokrow((u).tok + _h * 128 + gR[_i]) * (unsigned)(ld * 2) + (unsigned)gC2[_i]; } while (0)
    const size_t kstep = (size_t)(BK * 2);
    const size_t hstep = (size_t)HALF * ld * 2;
    const unsigned ldsw = (unsigned)wid * 1024u;
    const int aoff = lds_byte(wr * 64 + fr, fq * 8), boff = lds_byte(wc * 32 + fr, fq * 8);
#define PG8_SA(b, h) (((b) * 2 + (h)) * HTB)
#define PG8_SB(b, h) ((4 + (b) * 2 + (h)) * HTB)
#define PG8_STAGE(bufoff, gbase, voff) do { _Pragma("unroll") for (int _i = 0; _i < 2; ++_i) \
        __builtin_amdgcn_global_load_lds((const unsigned*)((const char*)(gbase) + (voff)[_i]), (LAS unsigned*)(lds + (bufoff) + ldsw + _i * 8192), 16, 0, 0); } while (0)
#define PG8_STAGE_A(bufoff, kptr, h, OFF) do { if constexpr (GA) PG8_STAGE(bufoff, kptr, OFF[h]); else PG8_STAGE(bufoff, (kptr) + (h) * hstep, voffA); } while (0)
#define PG8_LDA(dst, b, h) do { _Pragma("unroll") for (int m = 0; m < 4; ++m) _Pragma("unroll") for (int k = 0; k < 2; ++k) dst[m][k] = *(const LAS bf16x8*)(lds + PG8_SA(b, h) + aoff + m * 2048 + k * 1024); } while (0)
#define PG8_LDB(dst, b, h) do { _Pragma("unroll") for (int n = 0; n < 2; ++n) _Pragma("unroll") for (int k = 0; k < 2; ++k) dst[n][k] = *(const LAS bf16x8*)(lds + PG8_SB(b, h) + boff + n * 2048 + k * 1024); } while (0)
#define PG8_MMA(ai, bj, At, Bt) do { __builtin_amdgcn_s_setprio(1); _Pragma("unroll") for (int m = 0; m < 4; ++m) _Pragma("unroll") for (int n = 0; n < 2; ++n) _Pragma("unroll") for (int k = 0; k < 2; ++k) \
        acc[ai][bj][m][n] = __builtin_amdgcn_mfma_f32_16x16x32_bf16(Bt[n][k], At[m][k], acc[ai][bj][m][n], 0, 0, 0); __builtin_amdgcn_s_setprio(0); } while (0)
#define PG8_WAIT_V(n) asm volatile("s_waitcnt vmcnt(" #n ")" ::: "memory")
#define PG8_WAIT_L(n) asm volatile("s_waitcnt lgkmcnt(" #n ")" ::: "memory")
#define PG8_BAR __builtin_amdgcn_s_barrier()
#define PG8_SCHED __builtin_amdgcn_sched_barrier(0)
    Unit cur, nxt; int ui = 0;
    if (!S.next(0, cur)) return;
    f32x4 acc[2][2][4][2];
#pragma unroll
    for (int a = 0; a < 2; ++a)
#pragma unroll
        for (int b = 0; b < 2; ++b)
#pragma unroll
            for (int m = 0; m < 4; ++m)
#pragma unroll
                for (int n = 0; n < 2; ++n) acc[a][b][m][n] = (f32x4){0.f, 0.f, 0.f, 0.f};
    bf16x8 At[4][2], B0[2][2], B1[2][2];
    const char* cA = cur.A; const char* cB = cur.B;
    if constexpr (GA) { PG8_TOKOFF(oA, cur); }
    {
        PG8_STAGE(PG8_SB(0, 0), cB, voffB); PG8_STAGE(PG8_SB(0, 1), cB + hstep, voffB); PG8_STAGE_A(PG8_SA(0, 0), cA, 0, oA); PG8_STAGE_A(PG8_SA(0, 1), cA, 1, oA);
        if (wr == 1) PG8_BAR;
        PG8_WAIT_V(2); PG8_BAR;
        PG8_STAGE(PG8_SB(1, 0), cB + kstep, voffB); PG8_STAGE_A(PG8_SA(1, 0), cA + kstep, 0, oA); PG8_STAGE(PG8_SB(1, 1), cB + hstep + kstep, voffB);
        PG8_WAIT_V(6); PG8_BAR;
    }
    for (;;) {
        const bool has_next = S.next(ui + 1, nxt);
        const char* nA = has_next ? nxt.A : cA; const char* nB = has_next ? nxt.B : cB;
        if constexpr (GA) { if (has_next) { PG8_TOKOFF(nO, nxt); } else {
#pragma unroll
            for (int _h = 0; _h < 2; ++_h) { nO[_h][0] = oA[_h][0]; nO[_h][1] = oA[_h][1]; } } }
        for (int t = 0; t < nt; t += 2) {
            const bool last = (t == nt - 2);
            const char* a1 = cA + (size_t)(t + 1) * kstep;
            const char* a2 = last ? nA : cA + (size_t)(t + 2) * kstep; const char* b2 = last ? nB : cB + (size_t)(t + 2) * kstep;
            const char* a3 = a2 + kstep; const char* b3 = b2 + kstep;
            unsigned sO[2][2];
#pragma unroll
            for (int _h = 0; _h < 2; ++_h) { sO[_h][0] = last ? nO[_h][0] : oA[_h][0]; sO[_h][1] = last ? nO[_h][1] : oA[_h][1]; }
            PG8_LDB(B0, 0, 0); PG8_LDB(B1, 0, 1); PG8_SCHED; PG8_LDA(At, 0, 0); PG8_STAGE_A(PG8_SA(1, 1), a1, 1, oA);
            PG8_WAIT_V(8); PG8_WAIT_L(0); PG8_BAR; PG8_MMA(0, 0, At, B0); PG8_MMA(0, 1, At, B1); PG8_BAR; PG8_SCHED;
            PG8_LDA(At, 0, 1); PG8_STAGE(PG8_SB(0, 0), b2, voffB); PG8_STAGE(PG8_SB(0, 1), b2 + hstep, voffB); PG8_STAGE_A(PG8_SA(0, 0), a2, 0, sO);
            PG8_WAIT_V(8); PG8_WAIT_L(0); PG8_BAR; PG8_MMA(1, 0, At, B0); PG8_MMA(1, 1, At, B1); PG8_BAR; PG8_SCHED;
            PG8_LDB(B0, 1, 0); PG8_LDB(B1, 1, 1); PG8_SCHED; PG8_LDA(At, 1, 0); PG8_STAGE_A(PG8_SA(0, 1), a2, 1, sO);
            PG8_WAIT_V(8); PG8_WAIT_L(0); PG8_BAR; PG8_MMA(0, 0, At, B0); PG8_MMA(0, 1, At, B1); PG8_BAR; PG8_SCHED;
            PG8_LDA(At, 1, 1); PG8_STAGE(PG8_SB(1, 0), b3, voffB); PG8_STAGE(PG8_SB(1, 1), b3 + hstep, voffB); PG8_STAGE_A(PG8_SA(1, 0), a3, 0, sO);
            PG8_WAIT_V(8); PG8_WAIT_L(0); PG8_BAR; PG8_MMA(1, 0, At, B0); PG8_MMA(1, 1, At, B1); PG8_BAR; PG8_SCHED;
        }
        if (wr == 0) PG8_BAR;
        E(acc, cur, wr, wc, fr, fq);
        if (!has_next) break;
#pragma unroll
        for (int a = 0; a < 2; ++a)
#pragma unroll
            for (int b = 0; b < 2; ++b)
#pragma unroll
                for (int m = 0; m < 4; ++m)
#pragma unroll
                    for (int n = 0; n < 2; ++n) acc[a][b][m][n] = (f32x4){0.f, 0.f, 0.f, 0.f};
        cur = nxt; cA = nA; cB = nB; ++ui;
        if constexpr (GA) {
#pragma unroll
            for (int _h = 0; _h < 2; ++_h) { oA[_h][0] = nO[_h][0]; oA[_h][1] = nO[_h][1]; } }
        if (wr == 1) PG8_BAR;
    }
    PG8_WAIT_V(0);
    PG8_BAR;
#undef PG8_SA
#undef PG8_SB
#undef PG8_STAGE
#undef PG8_STAGE_A
#undef PG8_TOKOFF
#undef PG8_LDA
#undef PG8_LDB
#undef PG8_MMA
#undef PG8_WAIT_V
#undef PG8_WAIT_L
#undef PG8_BAR
#undef PG8_SCHED
}
}
using pg8::Unit;

DI void tr_item(const float* __restrict__ W, int N, int k0, int n0, bf16_t* __restrict__ WT, int ldt, int drow0, int dk0, LAS float* scr, int lane) {
    float tv[32];
    const float* wp = W + (size_t)(k0 + (lane >> 5)) * N + n0 + (lane & 31);
#pragma unroll
    for (int i = 0; i < 32; ++i) tv[i] = __builtin_nontemporal_load(wp + (size_t)(2 * i) * N);
#pragma unroll
    for (int i = 0; i < 32; ++i) scr[(2 * i + (lane >> 5)) * 33 + (lane & 31)] = tv[i];
    asm volatile("s_waitcnt lgkmcnt(0)" ::: "memory");
    const int c = lane & 7;
#pragma unroll
    for (int j = 0; j < 4; ++j) { const int n = (lane >> 3) + 8 * j; const LAS float* s = scr + (8 * c) * 33 + n;
        u32x4 o; o.x = cvt_pk_bf16(s[0 * 33], s[1 * 33]); o.y = cvt_pk_bf16(s[2 * 33], s[3 * 33]); o.z = cvt_pk_bf16(s[4 * 33], s[5 * 33]); o.w = cvt_pk_bf16(s[6 * 33], s[7 * 33]);
        *(u32x4*)(WT + (size_t)(drow0 + n) * ldt + dk0 + k0 + 8 * c) = o; }
    asm volatile("s_waitcnt lgkmcnt(0)" ::: "memory");
}
#define TRJOB(W_, K_, N_, WT_, LDT_, DROW_EXPR, DK0_) { const int _ni = ((K_) / 64) * ((N_) / 32); if (it < _ni) { const int _nb = (N_) / 32; const int _kb = it / _nb, _n0 = 32 * (it % _nb); const int n0 = _n0; (void)n0; \
        tr_item((W_), (N_), 64 * _kb, _n0, (WT_), (LDT_), (DROW_EXPR), (DK0_), scr, lane); return; } it -= _ni; }

DI void prologue_small_item(const Ctx& P, int it, LAS float* scr, int lane) {
    unsigned char* ws = P.ws;
    bf16_t* WAQKV = (bf16_t*)(ws + WS_WAQKV); bf16_t* WAO = (bf16_t*)(ws + WS_WAO); bf16_t* WCQKV = (bf16_t*)(ws + WS_WCQKV); bf16_t* WCO = (bf16_t*)(ws + WS_WCO);
    bf16_t* WBR = (bf16_t*)(ws + WS_WBRKVL); bf16_t* WBO = (bf16_t*)(ws + WS_WBO); bf16_t* WBL2 = (bf16_t*)(ws + WS_WBL2);
    TRJOB(P.in(I_AQKV), 1024, 1536, WAQKV, 1024, n0, 0)
    TRJOB(P.in(I_AQKV) + 1024 * 1536, 1024, 1536, WAQKV + 1536 * 1024, 1024, n0, 0)
    TRJOB(P.in(I_AO), 1024, 1024, WAO, 1024, n0, 0)
    TRJOB(P.in(I_AO) + 1024 * 1024, 1024, 1024, WAO + 1024 * 1024, 1024, n0, 0)
    TRJOB(P.in(I_CQKV), 1024, 1280, WCQKV, 1024, n0, 0)
    TRJOB(P.in(I_CO), 1024, 1024, WCO, 1024, n0, 0)
    TRJOB(P.in(I_BWR), 1024, 1024, WBR, 1024, n0, 0)
    TRJOB(P.in(I_BWK), 1024, 1024, WBR, 1024, 1024 + n0, 0)
    TRJOB(P.in(I_BWV), 1024, 1024, WBR, 1024, 2048 + n0, 0)
    TRJOB(P.in(I_BWO), 1024, 1024, WBO, 1024, n0, 0)
    TRJOB(P.in(I_BW1), 1024, 64, WBR, 1024, 3072 + n0, 0)
    TRJOB(P.in(I_BW1) + 65536, 1024, 64, WBR, 1024, 3072 + 64 + n0, 0)
    TRJOB(P.in(I_BA1), 1024, 64, WBR, 1024, 3328 + n0, 0)
    TRJOB(P.in(I_BA1) + 65536, 1024, 64, WBR, 1024, 3328 + 64 + n0, 0)
    TRJOB(P.in(I_BG1), 1024, 128, WBR, 1024, 3584 + n0, 0)
    TRJOB(P.in(I_BW2), 64, 1024, WBL2, 256, n0, 0)
    TRJOB(P.in(I_BW2) + 65536, 64, 1024, WBL2, 256, 1024 + n0, 64)
    TRJOB(P.in(I_BA2), 64, 1024, WBL2, 256, 2048 + n0, 128)
    TRJOB(P.in(I_BA2) + 65536, 64, 1024, WBL2, 256, 3072 + n0, 192)
    TRJOB(P.in(I_BG2), 128, 1024, WBL2, 256, 4096 + n0, 0)
}
constexpr int N_SMALL_ITEMS = 2 * 768 + 2 * 512 + 640 + 512 + 4 * 512 + 4 * 32 + 64 + 4 * 32 + 64;
constexpr int N_MOE_ITEMS_PER = 3 * 384, N_MOE_ITEMS = 128 * N_MOE_ITEMS_PER, N_MOE_PRO = 32 * N_MOE_ITEMS_PER;
static_assert(N_MOE_ITEMS - N_MOE_PRO == 108 * 1024, "scan-side conversion: 1024 staging waves x 108 chunks");
DI void prologue_moe_item(const Ctx& P, int item, LAS float* scr, int lane) {
    const int le = item / N_MOE_ITEMS_PER; int it = item % N_MOE_ITEMS_PER;
    bf16_t* W13 = (bf16_t*)(P.ws + WS_WM13) + (size_t)le * 1536 * 1024; bf16_t* W2 = (bf16_t*)(P.ws + WS_WM2) + (size_t)le * 1024 * 768;
    TRJOB(P.in(I_MW1) + (size_t)le * 1024 * 768, 1024, 768, W13, 1024, (n0 >> 7) * 256 + (n0 & 127), 0)
    TRJOB(P.in(I_MW3) + (size_t)le * 1024 * 768, 1024, 768, W13, 1024, (n0 >> 7) * 256 + 128 + (n0 & 127), 0)
    TRJOB(P.in(I_MW2) + (size_t)le * 768 * 1024, 768, 1024, W2, 768, n0, 0)
}

struct MoeItem { const float* src; bf16_t* dst; int N; };
DI MoeItem moe_item_decode(const float* w1, const float* w3, const float* w2, unsigned char* ws, int item, int lane, int& ldt) {
    const int le = item / N_MOE_ITEMS_PER, it = item % N_MOE_ITEMS_PER, job = it / 384, idx = it % 384;
    MoeItem m;
    if (job < 2) { const int kb = idx / 24, n0 = 32 * (idx % 24); m.N = 768; ldt = 1024;
        m.src = (job == 0 ? w1 : w3) + (size_t)le * 1024 * 768 + (size_t)(64 * kb + (lane >> 5)) * 768 + n0 + (lane & 31);
        m.dst = (bf16_t*)(ws + WS_WM13) + (size_t)le * 1536 * 1024 + (size_t)((n0 >> 7) * 256 + (job == 1 ? 128 : 0) + (n0 & 127)) * 1024 + 64 * kb;
    } else { const int kb = idx / 32, n0 = 32 * (idx % 32); m.N = 1024; ldt = 768;
        m.src = w2 + (size_t)le * 768 * 1024 + (size_t)(64 * kb + (lane >> 5)) * 1024 + n0 + (lane & 31);
        m.dst = (bf16_t*)(ws + WS_WM2) + (size_t)le * 1024 * 768 + (size_t)n0 * 768 + 64 * kb; }
    return m;
}
DI void moe_item_load(const MoeItem& m, float (&tv)[32]) {
#pragma unroll
    for (int i = 0; i < 32; ++i) tv[i] = __builtin_nontemporal_load(m.src + (size_t)(2 * i) * m.N);
}
DI void moe_item_store(const MoeItem& m, int ldt, const float (&tv)[32], LAS float* scr, int lane) {
#pragma unroll
    for (int i = 0; i < 32; ++i) scr[(2 * i + (lane >> 5)) * 33 + (lane & 31)] = tv[i];
    asm volatile("s_waitcnt lgkmcnt(0)" ::: "memory");
    const int c = lane & 7;
#pragma unroll
    for (int j = 0; j < 4; ++j) { const int n = (lane >> 3) + 8 * j; const LAS float* sp = scr + (8 * c) * 33 + n;
        u32x4 o; o.x = cvt_pk_bf16(sp[0 * 33], sp[1 * 33]); o.y = cvt_pk_bf16(sp[2 * 33], sp[3 * 33]); o.z = cvt_pk_bf16(sp[4 * 33], sp[5 * 33]); o.w = cvt_pk_bf16(sp[6 * 33], sp[7 * 33]);
        *(u32x4*)(m.dst + (size_t)n * ldt + 8 * c) = o; }
    asm volatile("s_waitcnt lgkmcnt(0)" ::: "memory");
}
DI void phase_prologue(const Ctx& P, LAS unsigned char* lds, int tid, int lane, int wave) {
    const int G = gridDim.x, bx = blockIdx.x;
    unsigned char* ws = P.ws;
    LAS float* cond = (LAS float*)lds;
    LAS float* part = (LAS float*)(lds + 12288);
    { const float* cp = P.in(I_C); const float* ccp = P.in(I_CCTX);
      for (int i = tid; i < 3072; i += 512) { const int v = i >> 10, k = i & 1023; const float c = (v < 2) ? cp[v * 1024 + k] : ccp[k]; cond[i] = silu_f(c); } }
    __syncthreads();
    float* MOD = (float*)(ws + WS_MOD);
    const float* modw = P.in(I_MODW); const float* modb = P.in(I_MODB);
    for (int u = bx; u < 4 * 96; u += G) {
        const int l = u / 96, c0 = (u % 96) * 64;
        const float* W = modw + (size_t)l * 1024 * 6144 + c0 + lane;
        float a0 = 0.f, a1 = 0.f, a2 = 0.f;
        const int kb = wave * 128;
#pragma unroll 16
        for (int k = 0; k < 128; ++k) { const float w = W[(size_t)(kb + k) * 6144]; a0 += cond[kb + k] * w; a1 += cond[1024 + kb + k] * w; a2 += cond[2048 + kb + k] * w; }
        part[(wave * 3 + 0) * 64 + lane] = a0; part[(wave * 3 + 1) * 64 + lane] = a1; part[(wave * 3 + 2) * 64 + lane] = a2;
        __syncthreads();
        if (tid < 192) { const int v = tid >> 6, c = tid & 63; float s = 0.f;
#pragma unroll
            for (int w = 0; w < 8; ++w) s += part[(w * 3 + v) * 64 + c];
            const int j = c0 + c; MOD[((size_t)(l * 3 + v) * 6 + (j >> 10)) * 1024 + (j & 1023)] = s + modb[l * 6144 + j]; }
        __syncthreads();
    }
    const int gt = bx * 512 + tid, NGT = G * 512;
    {
        float* RT = (float*)(ws + WS_ROPE);
        for (int i = gt; i < 128 * 16; i += NGT) { const int p = i >> 4, f = i & 15; const float inv = powf(10000.0f, -(float)(2 * f) / 32.0f); const float ang = (float)p * inv; RT[2 * i] = cosf(ang); RT[2 * i + 1] = sinf(ang); }
        float* WR = (float*)(ws + WS_WR); const float* mwg = P.in(I_MWG); const float* mwe = P.in(I_MWE);
        for (int i = gt; i < 4 * 36 * 1024; i += NGT) { const int l = i / (36 * 1024), r = i % (36 * 1024), j = r >> 10, k = r & 1023;
            WR[i] = (j < 4) ? mwg[((size_t)l * 1024 + k) * 4 + j] : mwe[((size_t)l * 1024 + k) * 32 + (j - 4)]; }
        bf16_t* WBR = (bf16_t*)(ws + WS_WBRKVL);
        for (int i = gt; i < 3 * 128 * 128; i += NGT) { const int seg = i / (128 * 128), r = (i / 128) % 128, ch = i % 128; *(u32x4*)(WBR + (size_t)(3072 + seg * 256 + 128 + r) * 1024 + ch * 8) = (u32x4){0u, 0u, 0u, 0u}; }
        bf16_t* WBL2 = (bf16_t*)(ws + WS_WBL2);
        for (int i = gt; i < 5120 * 32; i += NGT) { const int r = i >> 5, ch = i & 31, k = ch * 8; int lo, hi;
            if (r < 2048) { lo = 64 * (r >> 10); hi = lo + 64; } else if (r < 4096) { lo = 128 + 64 * ((r - 2048) >> 10); hi = lo + 64; } else { lo = 0; hi = 128; }
            if (k < lo || k >= hi) *(u32x4*)(WBL2 + (size_t)r * 256 + k) = (u32x4){0u, 0u, 0u, 0u}; }
    }
    LAS float* scr = (LAS float*)(lds + 20480 + wave * 8704);
    const int gw = bx * 8 + wave, NGW = G * 8;
    for (int it = gw; it < N_SMALL_ITEMS; it += NGW) prologue_small_item(P, it, scr, lane);
    const int n_moe_here = (G == 256) ? N_MOE_PRO : N_MOE_ITEMS;
    for (int it = gw; it < n_moe_here; it += NGW) prologue_moe_item(P, it, scr, lane);
}

DI void row_load(const float* p, int lane, f32x4 (&v)[4]) {
#pragma unroll
    for (int j = 0; j < 4; ++j) v[j] = ((const f32x4*)p)[lane + 64 * j];
}
DI void row_load_x(const bf16_t* p, int lane, f32x4 (&v)[4]) {
#pragma unroll
    for (int j = 0; j < 4; ++j) { const u32x2 w = ((const u32x2*)p)[lane + 64 * j]; v[j] = (f32x4){__uint_as_float(w[0] << 16), __uint_as_float(w[0] & 0xffff0000u), __uint_as_float(w[1] << 16), __uint_as_float(w[1] & 0xffff0000u)}; }
}
DI void row_store(float* p, int lane, const f32x4 (&v)[4]) {
#pragma unroll
    for (int j = 0; j < 4; ++j) ((f32x4*)p)[lane + 64 * j] = v[j];
}
DI void row_store_bf16(bf16_t* p, int lane, const f32x4 (&v)[4]) {
#pragma unroll
    for (int j = 0; j < 4; ++j) ((u32x2*)p)[lane + 64 * j] = (u32x2){cvt_pk_bf16(v[j][0], v[j][1]), cvt_pk_bf16(v[j][2], v[j][3])};
}
DI float row_sumsq(const f32x4 (&v)[4]) {
    float s = 0.f;
#pragma unroll
    for (int j = 0; j < 4; ++j) s += (v[j][0] * v[j][0] + v[j][1] * v[j][1]) + (v[j][2] * v[j][2] + v[j][3] * v[j][3]);
    return wave_sum(s);
}
DI int moe_tables(const Ctx& P, int l, LAS unsigned char* lds, int tid);
DI void moe_combine(const Ctx& P, int lprev, int row, int lane, f32x4 (&x)[4], const LAS int* start) {
    const unsigned char* ws = P.ws;
    const int2 e_ = ((const int2*)(ws + WS_TOK))[row], p_ = ((const int2*)(ws + WS_TOK + TOK_STRIDE))[row];
    const int2 d = make_int2(start[e_.x] + p_.x, start[e_.y] + p_.y);
    const float2 w = ((const float2*)(ws + WS_TOK + 2 * TOK_STRIDE))[row];
    const bf16_t* Y = (const bf16_t*)(ws + WS_YASG);
    const float* gate = (const float*)(ws + WS_MOD) + ((size_t)(lprev * 3 + vec_of_row(row)) * 6 + 5) * 1024;
#pragma unroll
    for (int j = 0; j < 4; ++j) {
        const u32x2 y0 = ((const u32x2*)(Y + (size_t)d.x * 1024))[lane + 64 * j], y1 = ((const u32x2*)(Y + (size_t)d.y * 1024))[lane + 64 * j];
        const f32x4 g = ((const f32x4*)gate)[lane + 64 * j];
        x[j][0] += g[0] * (w.x * bf_lo(y0.x) + w.y * bf_lo(y1.x)); x[j][1] += g[1] * (w.x * bf_hi(y0.x) + w.y * bf_hi(y1.x));
        x[j][2] += g[2] * (w.x * bf_lo(y0.y) + w.y * bf_lo(y1.y)); x[j][3] += g[3] * (w.x * bf_hi(y0.y) + w.y * bf_hi(y1.y));
    }
}
DI void modulate_row(const f32x4 (&x)[4], f32x4 (&h)[4], const float* g, const float* shift, const float* scale, int lane) {
    const float rstd = rsqrtf(row_sumsq(x) * (1.0f / DM) + NORM_EPS);
#pragma unroll
    for (int j = 0; j < 4; ++j) { const f32x4 gg = ((const f32x4*)g)[lane + 64 * j], sc = ((const f32x4*)scale)[lane + 64 * j], sh = ((const f32x4*)shift)[lane + 64 * j];
        h[j] = (x[j] * rstd) * gg * (sc + 1.0f) + sh; }
}

DI void phase_norm1(const Ctx& P, int l, bool rwkv, LAS unsigned char* lds, int tid, int lane, int gw, int NGW) {
    unsigned char* ws = P.ws;
    if (l > 0) (void)moe_tables(P, l - 1, lds, tid);
    const LAS int* start = (const LAS int*)(lds + LDS_MISC + MISC_START);
    bf16_t* XOUT = (bf16_t*)(ws + xres_of(l)); const bf16_t* XIN = (const bf16_t*)(ws + (l > 0 ? xres_of(l - 1) : WS_XRES)); const float* MOD = (const float*)(ws + WS_MOD);
    const float* xin = P.in(I_X); const float* cin = P.in(I_CTX); const float* n1g = P.in(I_N1G) + l * DM;
    if (!rwkv) {
        for (int row = gw; row < MROWS; row += NGW) {
            f32x4 x[4], h[4];
            if (l == 0) { row_load(row < NCTXR ? cin + (size_t)row * DM : xin + (size_t)(row - NCTXR) * DM, lane, x); row_store_bf16(XOUT + (size_t)row * DM, lane, x); }
            else { row_load_x(XIN + (size_t)row * DM, lane, x); moe_combine(P, l - 1, row, lane, x, start); row_store_bf16(XOUT + (size_t)row * DM, lane, x); }
            const float* m = MOD + (size_t)(l * 3 + vec_of_row(row)) * 6 * 1024;
            modulate_row(x, h, n1g, m, m + 1024, lane);
            row_store_bf16((bf16_t*)(ws + WS_HA0) + (size_t)row * DM, lane, h);
        }
        return;
    }
    bf16_t* MIX = (bf16_t*)(ws + WS_MIX); const float* mu = P.in(I_BMU);
    const int wv = gw & 7, blk = gw >> 3;
    for (int b66 = blk; b66 * 66 < MROWS; b66 += NGW >> 3) {
        const int r0 = b66 * 66 + (wv < 2 ? 9 * wv : 18 + 8 * (wv - 2)), r1 = r0 + (wv < 2 ? 9 : 8);
        f32x4 hm[4], hc[4], hn[4];
#pragma unroll
        for (int j = 0; j < 4; ++j) { hm[j] = (f32x4){0.f, 0.f, 0.f, 0.f}; hc[j] = hm[j]; hn[j] = hm[j]; }
        for (int i = r0 - 1; i <= r1; ++i) {
#pragma unroll
            for (int j = 0; j < 4; ++j) { hm[j] = hc[j]; hc[j] = hn[j]; }
            if (i >= 0 && i < MROWS) { f32x4 x[4];
                row_load_x(XIN + (size_t)i * DM, lane, x); moe_combine(P, l - 1, i, lane, x, start);
                if (i >= r0 && i < r1) row_store_bf16(XOUT + (size_t)i * DM, lane, x);
                const float* m = MOD + (size_t)(l * 3 + vec_of_row(i)) * 6 * 1024;
                modulate_row(x, hn, n1g, m, m + 1024, lane);
            } else {
#pragma unroll
                for (int j = 0; j < 4; ++j) hn[j] = (f32x4){0.f, 0.f, 0.f, 0.f}; }
            const int t = i - 1;
            if (t >= r0 && t < r1) {
                int tt, T; if (t < NCTXR) { tt = t & 255; T = NCTX; } else { tt = (t - NCTXR) & 8191; T = SEQ; }
                const float wp = tt > 0 ? 0.5f : 0.0f, wn = tt < T - 1 ? 0.5f : 0.0f;
                f32x4 xx[4];
#pragma unroll
                for (int j = 0; j < 4; ++j) xx[j] = hm[j] * wp + hn[j] * wn - hc[j];
#pragma unroll
                for (int q = 0; q < 6; ++q) { f32x4 o[4];
#pragma unroll
                    for (int j = 0; j < 4; ++j) o[j] = hc[j] + xx[j] * ((const f32x4*)(mu + q * DM))[lane + 64 * j];
                    row_store_bf16(MIX + (size_t)q * ROWB + (size_t)t * DM, lane, o); }
            }
        }
    }
}
DI void phase_final(const Ctx& P, LAS unsigned char* lds, int tid, int lane, int gw, int NGW) {
    (void)moe_tables(P, DEPTH - 1, lds, tid);
    const LAS int* start = (const LAS int*)(lds + LDS_MISC + MISC_START);
    const bf16_t* XRES = (const bf16_t*)(P.ws + xres_of(DEPTH - 1)); const float* fg = P.in(I_FG); float* outp = P.out;
    for (int row = NCTXR + gw; row < MROWS; row += NGW) {
        f32x4 x[4]; row_load_x(XRES + (size_t)row * DM, lane, x); moe_combine(P, DEPTH - 1, row, lane, x, start);
        const float rstd = rsqrtf(row_sumsq(x) * (1.0f / DM) + NORM_EPS);
#pragma unroll
        for (int j = 0; j < 4; ++j) { const f32x4 gg = ((const f32x4*)fg)[lane + 64 * j]; ((f32x4*)(outp + (size_t)(row - NCTXR) * DM))[lane + 64 * j] = (x[j] * rstd) * gg; }
    }
}
DI void phase_norm2_router(const Ctx& P, int l, LAS unsigned char* lds, int tid, int lane, int gw, int NGW, bool dry = false) {
    unsigned char* ws = P.ws;
    const bf16_t* XRES = (const bf16_t*)(ws + xres_of(l)); const float* MOD = (const float*)(ws + WS_MOD);
    bf16_t* HA0 = (bf16_t*)(ws + WS_HA0);
    LAS f32x4* WRl = (LAS f32x4*)lds;
    { const f32x4* src = (const f32x4*)((const float*)(ws + WS_WR) + (size_t)l * 36 * 1024);
      for (int i = tid; i < 36 * 256; i += 512) WRl[i] = src[i]; }
    __syncthreads();
    unsigned* CNT = (unsigned*)(ws + WS_CTL) + CW_CNT + l * 64;
    int* LIST = (int*)(ws + WS_LIST);
    int2* TOK_E = (int2*)(ws + WS_TOK); int2* TOK_POS = (int2*)(ws + WS_TOK + TOK_STRIDE); float2* TOK_W = (float2*)(ws + WS_TOK + 2 * TOK_STRIDE);
    const int row0 = (l == DEPTH - 1) ? NCTXR : 0;
    const float* n2g = P.in(I_N2G) + l * DM; const float* mbg = P.in(I_MBG) + l * 4; const float* mbe = P.in(I_MBE) + l * 32;
    for (int row = row0 + gw; row < MROWS; row += NGW) {
        f32x4 x[4], h[4];
        row_load_x(XRES + (size_t)row * DM, lane, x);
        if (row < NCTXR) {
            const float* part = (const float*)(ws + WS_PART) + (size_t)row * DM; const float* g1 = MOD + ((size_t)(l * 3 + 2) * 6 + 2) * 1024;
#pragma unroll
            for (int j = 0; j < 4; ++j) { f32x4 a = ((const f32x4*)part)[lane + 64 * j];
#pragma unroll
                for (int ks = 1; ks < 8; ++ks) a = a + ((const f32x4*)(part + (size_t)ks * NCTXR * DM))[lane + 64 * j];
                x[j] = x[j] + ((const f32x4*)g1)[lane + 64 * j] * a; }
            row_store_bf16((bf16_t*)(ws + xres_of(l)) + (size_t)row * DM, lane, x);
        }
        const float* m = MOD + ((size_t)(l * 3 + vec_of_row(row)) * 6 + 3) * 1024;
        modulate_row(x, h, n2g, m, m + 1024, lane);
        row_store_bf16(HA0 + (size_t)row * DM, lane, h);
        float grp[9];
#pragma unroll
        for (int g = 0; g < 9; ++g) { float pt[4];
#pragma unroll
            for (int q = 0; q < 4; ++q) { const int e = 4 * g + q; f32x4 a = h[0] * WRl[e * 256 + lane];
#pragma unroll
                for (int j = 1; j < 4; ++j) a = h[j] * WRl[e * 256 + lane + 64 * j] + a;
                pt[q] = (a[0] + a[1]) + (a[2] + a[3]); }
            float t4 = merge4_reduce16(pt[0], pt[1], pt[2], pt[3], lane);
            t4 += __shfl_xor(t4, 16); t4 += __shfl_xor(t4, 32);
            grp[g] = t4; __builtin_amdgcn_sched_barrier(0); }
        float lg[4];
#pragma unroll
        for (int e = 0; e < 4; ++e) lg[e] = __builtin_bit_cast(float, __builtin_amdgcn_readlane(__builtin_bit_cast(int, grp[0]), e)) + mbg[e];
        int gi = 0; float gm = lg[0];
#pragma unroll
        for (int e = 1; e < 4; ++e) if (lg[e] > gm) { gm = lg[e]; gi = e; }
        float gs = 0.f;
#pragma unroll
        for (int e = 0; e < 4; ++e) gs += __expf(lg[e] - gm);
        const float gwt = 1.0f / gs;
        const float elA = (gi == 0) ? grp[1] : (gi == 1) ? grp[3] : (gi == 2) ? grp[5] : grp[7];
        const float elB = (gi == 0) ? grp[2] : (gi == 1) ? grp[4] : (gi == 2) ? grp[6] : grp[8];
        float el[8];
#pragma unroll
        for (int k = 0; k < 4; ++k) { el[k] = __builtin_bit_cast(float, __builtin_amdgcn_readlane(__builtin_bit_cast(int, elA), k)) + mbe[8 * gi + k];
                                      el[4 + k] = __builtin_bit_cast(float, __builtin_amdgcn_readlane(__builtin_bit_cast(int, elB), k)) + mbe[8 * gi + 4 + k]; }
        int i1 = 0; float m1 = el[0];
#pragma unroll
        for (int k = 1; k < 8; ++k) if (el[k] > m1) { m1 = el[k]; i1 = k; }
        int i2 = -1; float m2 = -3.0e38f;
#pragma unroll
        for (int k = 0; k < 8; ++k) if (k != i1 && el[k] > m2) { m2 = el[k]; i2 = k; }
        const float r = __expf(m2 - m1);
        const float w1 = gwt / (1.0f + r), w2 = gwt * r / (1.0f + r);
        if (lane == 0 && !dry) {
            const int e1 = gi * 8 + i1, e2 = gi * 8 + i2;
            const int p1 = (int)atomicAdd(&CNT[e1], 1u), p2 = (int)atomicAdd(&CNT[e2], 1u);
            TOK_E[row] = make_int2(e1, e2); TOK_POS[row] = make_int2(p1, p2); TOK_W[row] = make_float2(w1, w2);
            LIST[(size_t)e1 * MROWS + p1] = row; LIST[(size_t)e2 * MROWS + p2] = row;
        }
    }
}
DI int moe_tables(const Ctx& P, int l, LAS unsigned char* lds, int tid) {
    LAS int* start = (LAS int*)(lds + LDS_MISC + MISC_START); LAS int* blk_e = (LAS int*)(lds + LDS_MISC + MISC_BLKE);
    const unsigned* CNT = (const unsigned*)(P.ws + WS_CTL) + CW_CNT + l * 64;
    LAS int* cnt_l = (LAS int*)(lds + LDS_MISC + MISC_CNTL);
    __syncthreads();
    if (tid < NEXP) cnt_l[tid] = (int)__hip_atomic_load(CNT + tid, __ATOMIC_RELAXED, __HIP_MEMORY_SCOPE_AGENT);
    __syncthreads();
    if (tid == 0) { int s = 0; for (int e = 0; e < NEXP; ++e) { start[e] = s; const int nb = (cnt_l[e] + 255) >> 8; for (int b = 0; b < nb; ++b) blk_e[(s >> 8) + b] = e; s += nb << 8; } start[NEXP] = s; }
    __syncthreads();
    return start[NEXP] >> 8;
}
template <int WGM = 8> DI bool unit_order(int i, int G, int c, int nM, int nN, int& pm, int& pn) {
    const int nwg = nM * nN, L = i * G + c; if (L >= nwg) return false;
    int w; { const int q = nwg / 8, r = nwg % 8, xcd = L % 8, off = L / 8; w = (xcd < r ? xcd * (q + 1) : r * (q + 1) + (xcd - r) * q) + off; }
    const int nig = WGM * nN, gid = w / nig, fm = gid * WGM, gsz = (nM - fm) < WGM ? (nM - fm) : WGM;
    pm = fm + ((w % nig) % gsz); pn = (w % nig) / gsz; return true;
}
struct SchedDense {
    static constexpr bool GATHER = false;
    const char* A; const char* B; int nM, nN, G, c, pm0; size_t tileb;
    DI bool next(int i, Unit& u) const { int pm, pn; if (!unit_order(i, G, c, nM, nN, pm, pn)) return false; u.pm = pm0 + pm; u.pn = pn; u.A = A + (size_t)u.pm * tileb; u.B = B + (size_t)u.pn * tileb; return true; }
};
struct SchedCtxSplit {
    static constexpr bool GATHER = false;
    static constexpr bool HOOKS = false;
    const char* A; const char* B; int c;
    DI bool next(int i, Unit& u) const { if (i > 0 || c >= 64) return false; const int ks = c & 7, pn = (c >> 3) & 3; u.pm = c >> 5; u.pn = pn | (ks << 2);
        u.A = A + (size_t)u.pm * (256 * 1024 * 2) + ks * 256; u.B = B + (size_t)pn * (256 * 1024 * 2) + ks * 256; return true; }
};
struct SchedRkvl {
    static constexpr bool GATHER = false;
    const char* MIX; const char* B; int G, c;
    DI bool next(int i, Unit& u) const { if (!unit_order(i, G, c, 66, 15, u.pm, u.pn)) return false;
        const int slot = u.pn < 4 ? 0 : u.pn < 8 ? 2 : u.pn < 12 ? 3 : u.pn == 12 ? 1 : u.pn == 13 ? 4 : 5;
        u.A = MIX + (size_t)slot * ROWB * 2 + (size_t)u.pm * 256 * 1024 * 2; u.B = B + (size_t)u.pn * 256 * 1024 * 2; return true; }
};
struct SchedLora2 {
    static constexpr bool GATHER = false;
    const char* TWA; const char* TG; const char* B; int G, c;
    DI bool next(int i, Unit& u) const { if (!unit_order(i, G, c, 66, 20, u.pm, u.pn)) return false;
        const int ko = (u.pn >= 8 && u.pn < 16) ? 256 : 0;
        u.A = (u.pn < 16 ? TWA : TG) + (size_t)u.pm * 256 * 256 * 2 + ko; u.B = B + (size_t)u.pn * 256 * 256 * 2 + ko; return true; }
};
struct SchedMoe {
    static constexpr bool GATHER = false;
    const char* A; const char* B; int nM, nN, G, c; size_t atile, btile, bexp; const LAS int* blk_e;
    DI bool next(int i, Unit& u) const { if (!unit_order<2>(i, G, c, nM, nN, u.pm, u.pn)) return false;
        u.A = A + (size_t)u.pm * atile; u.B = B + (size_t)blk_e[u.pm] * bexp + (size_t)u.pn * btile; return true; }
};

struct SchedMoeG {
    static constexpr bool GATHER = true;
    const char* A; const char* B; int nM, G, c; const LAS int* blk_e; const LAS int* ltok;
    DI bool next(int i, Unit& u) const { if (!unit_order<2>(i, G, c, nM, 6, u.pm, u.pn)) return false;
        u.A = A; u.B = B + (size_t)blk_e[u.pm] * ((size_t)1536 * 1024 * 2) + (size_t)u.pn * (256 * 1024 * 2); u.tok = i * 256; return true; }
    DI int tokrow(int idx) const { return ltok[idx]; }
};
constexpr int LDS_LTOK = 131072;
#define EPI_LOOP_BEGIN _Pragma("unroll") for (int ai = 0; ai < 2; ++ai) _Pragma("unroll") for (int m = 0; m < 4; ++m) { const int row = u.pm * 256 + ai * 128 + wr * 64 + m * 16 + fr;
#define EPI_LOOP_END }
DI u32x4 pack8_bf16(const f32x4& a, const f32x4& b) { return (u32x4){cvt_pk_bf16(a[0], a[1]), cvt_pk_bf16(a[2], a[3]), cvt_pk_bf16(b[0], b[1]), cvt_pk_bf16(b[2], b[3])}; }
DI h16x8 pack8_h16(const f32x4& a, const f32x4& b) { return (h16x8){(h16)a[0], (h16)a[1], (h16)a[2], (h16)a[3], (h16)b[0], (h16)b[1], (h16)b[2], (h16)b[3]}; }

DI f32x4 sigmoid4(f32x4 x) { f32x4 r; r[0] = sigmoid_f(x[0]); r[1] = sigmoid_f(x[1]); r[2] = sigmoid_f(x[2]); r[3] = sigmoid_f(x[3]); return r; }
DI float decay_e(float wl) { const float lw = -0.6065306597126334f * __builtin_amdgcn_rcpf(1.0f + __expf(-wl)); return 1.0f - __expf(lw); }
DI f32x4 decay_e4(f32x4 x) { f32x4 r; r[0] = decay_e(x[0]); r[1] = decay_e(x[1]); r[2] = decay_e(x[2]); r[3] = decay_e(x[3]); return r; }
DI float tanh_f(float x) { return 1.0f - 2.0f * __builtin_amdgcn_rcpf(__expf(2.0f * x) + 1.0f); }
struct EpiQKV {
    static constexpr bool PERM = true;
    bf16_t* Q; bf16_t* K; bf16_t* V; int dense; const float* qgain; const float* kgain; const float* RT; LAS float* xch;
    DI void operator()(const f32x4 (&acc)[2][2][4][2], const Unit& u, int wr, int wc, int fr, int fq) const {
        if (dense && u.pn == 5) {
            EPI_LOOP_BEGIN
                bf16_t* dst = V + (size_t)kvrow_of(row) * 256 + wc * 32 + 8 * fq;
#pragma unroll
                for (int bj = 0; bj < 2; ++bj) *(u32x4*)(dst + bj * 128) = pack8_bf16(acc[ai][bj][m][0], acc[ai][bj][m][1]);
            EPI_LOOP_END
            return;
        }
        const bool isQ = u.pn < 4; const int wid = wr * 4 + wc; const bool lat = u.pm >= 2; const int axis = wc & 1;
        if (dense) {
#pragma unroll
            for (int ai = 0; ai < 2; ++ai)
#pragma unroll
                for (int bj = 0; bj < 2; ++bj)
#pragma unroll
                    for (int m = 0; m < 4; ++m) { const f32x4 a = acc[ai][bj][m][0], b = acc[ai][bj][m][1];
                        float ss = (a[0] * a[0] + a[1] * a[1]) + (a[2] * a[2] + a[3] * a[3]) + (b[0] * b[0] + b[1] * b[1]) + (b[2] * b[2] + b[3] * b[3]);
                        ss += __shfl_xor(ss, 16); ss += __shfl_xor(ss, 32);
                        if (fq == 0) xch[wid * 256 + ((ai * 2 + bj) * 4 + m) * 16 + fr] = ss; }
            asm volatile("s_waitcnt lgkmcnt(0)" ::: "memory"); __builtin_amdgcn_s_barrier(); asm volatile("" ::: "memory");
        }
        const int d0 = (32 * wc + 8 * fq) & 63;
        const float scale = isQ ? C2 : 1.0f;
        f32x4 g0 = (f32x4){scale, scale, scale, scale}, g1 = g0;
        if (dense) { const float* gp = (isQ ? qgain : kgain) + d0; g0 = *(const f32x4*)gp * scale; g1 = *(const f32x4*)(gp + 4) * scale; }
        EPI_LOOP_BEGIN
            const size_t kr = (size_t)kvrow_of(row);
            const int t = (row - NCTXR) & 8191, pos = axis ? (t & 63) : (t >> 6);
            const float* rt = RT + pos * 32 + ((8 * fq) & 15) * 2;
            f32x4 c0 = (f32x4){1.f, 0.f, 1.f, 0.f}, c1 = c0, c2 = c0, c3 = c0;
            if (lat) { c0 = *(const f32x4*)rt; c1 = *(const f32x4*)(rt + 4); c2 = *(const f32x4*)(rt + 8); c3 = *(const f32x4*)(rt + 12); }
#pragma unroll
            for (int bj = 0; bj < 2; ++bj) {
                if (!dense && !isQ && bj == 1) { *(u32x4*)(V + kr * 128 + wc * 32 + 8 * fq) = pack8_bf16(acc[ai][1][m][0], acc[ai][1][m][1]); continue; }
                f32x4 a = acc[ai][bj][m][0] * g0, b = acc[ai][bj][m][1] * g1;
                if (dense) { const int xi = ((ai * 2 + bj) * 4 + m) * 16 + fr; const float rs = rsqrtf((xch[wid * 256 + xi] + xch[(wid ^ 1) * 256 + xi]) * (1.0f / 64.0f) + NORM_EPS); a = a * rs; b = b * rs; }
                if (lat) {
                    f32x4 pa, pb;
#pragma unroll
                    for (int q = 0; q < 4; ++q) { pa[q] = __shfl_xor(a[q], 32); pb[q] = __shfl_xor(b[q], 32); }
                    const float sg = fq < 2 ? -1.0f : 1.0f;
                    a[0] = a[0] * c0[0] + sg * pa[0] * c0[1]; a[1] = a[1] * c0[2] + sg * pa[1] * c0[3]; a[2] = a[2] * c1[0] + sg * pa[2] * c1[1]; a[3] = a[3] * c1[2] + sg * pa[3] * c1[3];
                    b[0] = b[0] * c2[0] + sg * pb[0] * c2[1]; b[1] = b[1] * c2[2] + sg * pb[1] * c2[3]; b[2] = b[2] * c3[0] + sg * pb[2] * c3[1]; b[3] = b[3] * c3[2] + sg * pb[3] * c3[3];
                }
                bf16_t* dst = isQ ? Q + (size_t)row * DM + u.pn * 256 : K + kr * (dense ? 256 : 128);
                *(u32x4*)(dst + bj * 128 + wc * 32 + 8 * fq) = pack8_bf16(a, b);
            }
        EPI_LOOP_END
    }
};
struct EpiResid {
    static constexpr bool PERM = true;
    bf16_t* X; const float* gate_l; float scale;
    DI void operator()(const f32x4 (&acc)[2][2][4][2], const Unit& u, int wr, int wc, int fr, int fq) const {
        const int v = u.pm < 2 ? 2 : ((u.pm - 2) >> 5);
        const float* g = gate_l + (size_t)v * 6 * 1024;
        EPI_LOOP_BEGIN
#pragma unroll
            for (int bj = 0; bj < 2; ++bj) { const int col = u.pn * 256 + bj * 128 + wc * 32 + 8 * fq; u32x4* p = (u32x4*)(X + (size_t)row * DM + col); const u32x4 w = *p;
                const f32x4 g0 = *(const f32x4*)(g + col), g1 = *(const f32x4*)(g + col + 4);
                const f32x4 x0 = (f32x4){__uint_as_float(w[0] << 16), __uint_as_float(w[0] & 0xffff0000u), __uint_as_float(w[1] << 16), __uint_as_float(w[1] & 0xffff0000u)};
                const f32x4 x1 = (f32x4){__uint_as_float(w[2] << 16), __uint_as_float(w[2] & 0xffff0000u), __uint_as_float(w[3] << 16), __uint_as_float(w[3] & 0xffff0000u)};
                *p = pack8_bf16(x0 + g0 * acc[ai][bj][m][0] * scale, x1 + g1 * acc[ai][bj][m][1] * scale); }
        EPI_LOOP_END
    }
};
struct EpiPartial {
    static constexpr bool PERM = false;
    float* PART;
    DI void operator()(const f32x4 (&acc)[2][2][4][2], const Unit& u, int wr, int wc, int fr, int fq) const {
        const int pn = u.pn & 3, ks = u.pn >> 2;
        EPI_LOOP_BEGIN
#pragma unroll
            for (int bj = 0; bj < 2; ++bj)
#pragma unroll
                for (int n = 0; n < 2; ++n) *(f32x4*)(PART + ((size_t)ks * NCTXR + row) * DM + pn * 256 + bj * 128 + wc * 32 + n * 16 + 4 * fq) = acc[ai][bj][m][n];
        EPI_LOOP_END
    }
};
struct EpiRkvl {
    static constexpr bool PERM = true;
    h16* RKV; bf16_t* TWA; bf16_t* TG;
    DI void operator()(const f32x4 (&acc)[2][2][4][2], const Unit& u, int wr, int wc, int fr, int fq) const {
        EPI_LOOP_BEGIN
            const int c8 = wc * 32 + 8 * fq;
            if (u.pn < 12) { h16* dst = RKV + (size_t)(u.pn >> 2) * ROWB + (size_t)row * DM + (u.pn & 3) * 256 + c8;
#pragma unroll
                for (int bj = 0; bj < 2; ++bj) *(h16x8*)(dst + bj * 128) = pack8_h16(acc[ai][bj][m][0], acc[ai][bj][m][1]);
            } else if (u.pn == 12) { f32x4 a = acc[ai][0][m][0], b = acc[ai][0][m][1];
#pragma unroll
                for (int q = 0; q < 4; ++q) { a[q] = tanh_f(a[q]); b[q] = tanh_f(b[q]); }
                *(u32x4*)(TWA + (size_t)row * 256 + c8) = pack8_bf16(a, b);
            } else if (u.pn == 13) { *(u32x4*)(TWA + (size_t)row * 256 + 128 + c8) = pack8_bf16(acc[ai][0][m][0], acc[ai][0][m][1]);
            } else { f32x4 a = acc[ai][0][m][0], b = acc[ai][0][m][1];
#pragma unroll
                for (int q = 0; q < 4; ++q) { a[q] = sigmoid_f(a[q]); b[q] = sigmoid_f(b[q]); }
                *(u32x4*)(TG + (size_t)row * 256 + c8) = pack8_bf16(a, b); *(u32x4*)(TG + (size_t)row * 256 + 128 + c8) = (u32x4){0x3f003f00u, 0x3f003f00u, 0x3f003f00u, 0x3f003f00u}; }
        EPI_LOOP_END
    }
};
struct EpiLora2 {
    static constexpr bool PERM = true;
    h16* EA; bf16_t* Gm; const float* w0; const float* a0;
    DI void operator()(const f32x4 (&acc)[2][2][4][2], const Unit& u, int wr, int wc, int fr, int fq) const {
        const int seg = u.pn >> 3, dir = (u.pn >> 2) & 1, colt = (u.pn & 3) * 256;
#pragma unroll
        for (int bj = 0; bj < 2; ++bj) {
            const int col = colt + bj * 128 + wc * 32 + 8 * fq;
            f32x4 wa = (f32x4){0.f, 0.f, 0.f, 0.f}, wb = wa;
            if (seg < 2) { const float* bp = (seg == 0 ? w0 : a0) + dir * 1024 + col; wa = *(const f32x4*)bp; wb = *(const f32x4*)(bp + 4); }
            h16* eo = EA + (size_t)(2 * seg + dir) * ROWB + col;
#pragma unroll
            for (int ai = 0; ai < 2; ++ai)
#pragma unroll
                for (int m = 0; m < 4; ++m) {
                    const int row = u.pm * 256 + ai * 128 + wr * 64 + m * 16 + fr;
                    f32x4 a = acc[ai][bj][m][0] + wa, b = acc[ai][bj][m][1] + wb;
                    if (seg == 0) { a = decay_e4(a); b = decay_e4(b); *(h16x8*)(eo + (size_t)row * DM) = pack8_h16(a, b); }
                    else if (seg == 1) { a = sigmoid4(a); b = sigmoid4(b); *(h16x8*)(eo + (size_t)row * DM) = pack8_h16(a, b); }
                    else *(u32x4*)(Gm + (size_t)row * DM + col) = pack8_bf16(a, b);
                    __builtin_amdgcn_sched_barrier(0);
                }
        }
    }
};
struct EpiMoe1 {
    static constexpr bool PERM = true;
    bf16_t* H;
    DI void operator()(const f32x4 (&acc)[2][2][4][2], const Unit& u, int wr, int wc, int fr, int fq) const {
        EPI_LOOP_BEGIN
            f32x4 a = acc[ai][0][m][0], b = acc[ai][0][m][1]; const f32x4 a3 = acc[ai][1][m][0], b3 = acc[ai][1][m][1];
#pragma unroll
            for (int q = 0; q < 4; ++q) { a[q] = silu_f(a[q]) * a3[q]; b[q] = silu_f(b[q]) * b3[q]; }
            *(u32x4*)(H + (size_t)row * DEXP + u.pn * 128 + wc * 32 + 8 * fq) = pack8_bf16(a, b);
        EPI_LOOP_END
    }
};
struct EpiMoe2 {
    static constexpr bool PERM = true;
    bf16_t* Y;
    DI void operator()(const f32x4 (&acc)[2][2][4][2], const Unit& u, int wr, int wc, int fr, int fq) const {
        EPI_LOOP_BEGIN
#pragma unroll
            for (int bj = 0; bj < 2; ++bj) *(u32x4*)(Y + (size_t)row * DM + u.pn * 256 + bj * 128 + wc * 32 + 8 * fq) = pack8_bf16(acc[ai][bj][m][0], acc[ai][bj][m][1]);
        EPI_LOOP_END
    }
};

DI int crow(int i, int hi) { return (i & 3) + 8 * (i >> 2) + 4 * hi; }

namespace attn_dense {
using bf16=unsigned short;
constexpr int D=64,DMQ=1024,NTILES=132;
constexpr int NW=8,QBLK=32,QB=QBLK*NW,KVBLK=64;
#define SBAR() __builtin_amdgcn_sched_barrier(0)
constexpr int NSLOT=3, SLOTB=8192;
constexpr int LDS_K=0, LDS_V=NSLOT*SLOTB, LDS_WS=2*NSLOT*SLOTB, LDS_OST=LDS_WS+NW*64*4, LDS_BYTES=LDS_OST+NW*4096;
constexpr float C2=0.125f*1.4426950408889634f;
__device__ __forceinline__ void glds16(const void*gsrc,unsigned lds_dst){unsigned keep;
  asm volatile("s_mov_b32 %0, m0\n\ts_mov_b32 m0, %2\n\ts_nop 0\n\tglobal_load_lds_dwordx4 %1, off\n\ts_mov_b32 m0, %0":"=&s"(keep):"v"(gsrc),"s"(lds_dst):"memory");}
__device__ __forceinline__ float max3f(float a,float b,float c){float r;asm("v_max3_f32 %0, %1, %2, %3":"=v"(r):"v"(a),"v"(b),"v"(c));return r;}
__device__ __forceinline__ float max2f(float a,float b){float r;asm("v_max_f32_e32 %0, %1, %2":"=v"(r):"v"(a),"v"(b));return r;}
__device__ __forceinline__ float fadd_s(float a,float b){float r;asm("v_add_f32_e32 %0, %1, %2":"=v"(r):"v"(a),"v"(b));return r;}
__device__ __forceinline__ float fsub_s(float a,float b){float r;asm("v_sub_f32_e32 %0, %1, %2":"=v"(r):"v"(a),"v"(b));return r;}
typedef float f32x2_t __attribute__((ext_vector_type(2)));
__device__ __forceinline__ unsigned cvtpk_s(float lo,float hi){f32x2_t v={lo,hi};bf16x2_t b=__builtin_convertvector(v,bf16x2_t);return __builtin_bit_cast(unsigned,b);}
#define WAIT_BAR(N) asm volatile("s_waitcnt vmcnt(" #N ") lgkmcnt(0)\n\ts_barrier":::"memory")

__device__ __forceinline__ void qkt(f32x16&p0,f32x16&p1,const char*Kslot,const bf16x8*qr,const f32x16&negm,int r32,int hi){
  const char*kb=Kslot+hi*1024+r32*16;
  #pragma unroll
  for(int d0=0;d0<4;++d0){
    const bf16x8 b0=*reinterpret_cast<const bf16x8*>(kb+d0*2048);
    const bf16x8 b1=*reinterpret_cast<const bf16x8*>(kb+d0*2048+512);
    if(d0==0){p0=__builtin_amdgcn_mfma_f32_32x32x16_bf16(b0,qr[0],negm,0,0,0);p1=__builtin_amdgcn_mfma_f32_32x32x16_bf16(b1,qr[0],negm,0,0,0);}
    else{p0=__builtin_amdgcn_mfma_f32_32x32x16_bf16(b0,qr[d0],p0,0,0,0);p1=__builtin_amdgcn_mfma_f32_32x32x16_bf16(b1,qr[d0],p1,0,0,0);}}
}
typedef __attribute__((address_space(3))) const char* lds_cptr;
typedef short v4i16_t __attribute__((ext_vector_type(4)));
__device__ __forceinline__ void kload8(bf16x8*kf,lds_cptr kp){
  kf[0]=*(const __attribute__((address_space(3))) bf16x8*)(kp);      kf[1]=*(const __attribute__((address_space(3))) bf16x8*)(kp+512);
  kf[2]=*(const __attribute__((address_space(3))) bf16x8*)(kp+2048); kf[3]=*(const __attribute__((address_space(3))) bf16x8*)(kp+2560);
  kf[4]=*(const __attribute__((address_space(3))) bf16x8*)(kp+4096); kf[5]=*(const __attribute__((address_space(3))) bf16x8*)(kp+4608);
  kf[6]=*(const __attribute__((address_space(3))) bf16x8*)(kp+6144); kf[7]=*(const __attribute__((address_space(3))) bf16x8*)(kp+6656);
}
__device__ __forceinline__ void kload2(bf16x8*kf,lds_cptr kp,int j){ kf[2*j]=*(const __attribute__((address_space(3))) bf16x8*)(kp+j*2048); kf[2*j+1]=*(const __attribute__((address_space(3))) bf16x8*)(kp+j*2048+512); }
__device__ __forceinline__ s16x4 vtr(lds_cptr p){ return __builtin_bit_cast(s16x4,__builtin_amdgcn_ds_read_tr16_b64_v4i16((__attribute__((address_space(3))) v4i16_t*)p)); }
__device__ __forceinline__ float rowmax(const f32x16&p0,const f32x16&p1){
  float a=max3f(p0[0],p0[1],p1[0]),b=max3f(p0[2],p0[3],p1[1]);a=max3f(a,p1[2],p1[3]);
  #pragma unroll
  for(int r=4;r<16;r+=4){a=max3f(a,p0[r],p0[r+1]);b=max3f(b,p0[r+2],p0[r+3]);a=max3f(a,p1[r],p1[r+1]);b=max3f(b,p1[r+2],p1[r+3]);}
  const float m=max2f(a,b);
  auto rr=__builtin_amdgcn_permlane32_swap(__float_as_uint(m),__float_as_uint(m),false,false);
  return max2f(__uint_as_float(rr[0]),__uint_as_float(rr[1]));
}
__device__ __forceinline__ void pv(f32x16*o,int vb,bf16x8 pa0,bf16x8 pa1,bf16x8 pa2,bf16x8 pa3){
  #pragma unroll
  for(int d0=0;d0<2;++d0){s16x4 lo[4],hi[4];
    #pragma unroll
    for(int ks=0;ks<4;++ks){
      asm volatile("ds_read_b64_tr_b16 %0,%1 offset:%c2":"=&v"(lo[ks]):"v"(vb),"i"(d0*4096+ks*1024):"memory");
      asm volatile("ds_read_b64_tr_b16 %0,%1 offset:%c2":"=&v"(hi[ks]):"v"(vb),"i"(d0*4096+ks*1024+512):"memory");}
    asm volatile("s_waitcnt lgkmcnt(0)":::"memory");SBAR();
    #define PK(k) (bf16x8){lo[k][0],lo[k][1],lo[k][2],lo[k][3],hi[k][0],hi[k][1],hi[k][2],hi[k][3]}
    o[d0]=__builtin_amdgcn_mfma_f32_32x32x16_bf16(pa0,PK(0),o[d0],0,0,0);
    o[d0]=__builtin_amdgcn_mfma_f32_32x32x16_bf16(pa1,PK(1),o[d0],0,0,0);
    o[d0]=__builtin_amdgcn_mfma_f32_32x32x16_bf16(pa2,PK(2),o[d0],0,0,0);
    o[d0]=__builtin_amdgcn_mfma_f32_32x32x16_bf16(pa3,PK(3),o[d0],0,0,0);
    #undef PK
  }
}

#ifndef ATTN_STORE16
#define ATTN_STORE16(p,v) (*(u32x4*)(p)=(v))
#endif
__device__ __forceinline__ void wmask(f32x16&p0,f32x16&p1,int kp0,int qpos,int hi){
  const float NEG=-INFINITY; const int kb=kp0+4*hi;
  #pragma unroll
  for(int r=0;r<16;++r){const int kv=kb+(r&3)+8*(r>>2); int d0=qpos-kv; d0=d0<0?-d0:d0; int d1=qpos-kv-32; d1=d1<0?-d1:d1; if(d0>128)p0[r]=NEG; if(d1>128)p1[r]=NEG;}
}
template<int THRL,int KVP,bool WIN> __device__ __forceinline__ void attn_unit(int qrow0,int kvrow0,int h,int kvh,const bf16*Q,const bf16*__restrict__ K,const bf16*__restrict__ V,bf16*O,char*shm,int nt_arg,int wlo,int qpos0,float sink2,const int tid){
  const int lane=tid&63,r32=lane&31,hi=lane>>5; const int wid=__builtin_amdgcn_readfirstlane(tid>>6);
  const bf16*Qw=Q+((long)qrow0+wid*QBLK)*DMQ+h*D;
  const bf16*Kh=K+(long)kvrow0*KVP+kvh*D,*Vh=V+(long)kvrow0*KVP+kvh*D;
  const unsigned lds0=(unsigned)(uintptr_t)shm;
  float*wsf=(float*)(shm+LDS_WS)+wid*64;
  const bf16*ksrc=Kh+(long)lane*KVP+wid*8;
  const bf16*vsrc=Vh+(long)(16*(wid&3)+(lane>>2))*KVP+(wid>>2)*32+(lane&3)*8;
  const unsigned kdst=lds0+LDS_K+wid*1024, vdst=lds0+LDS_V+wid*1024;
  #define TROW(t) (WIN ? ((t)<4 ? 64*(t) : 256+wlo+64*((t)-4)) : 64*(t))
  #define DMA_K(t,slot) glds16(ksrc+(long)TROW(t)*KVP,(unsigned)__builtin_amdgcn_readfirstlane(kdst+(slot)))
  #define DMA_V(t,slot) glds16(vsrc+(long)TROW(t)*KVP,(unsigned)__builtin_amdgcn_readfirstlane(vdst+(slot)))
  const int vb0=(int)(lds0+LDS_V)+((lane>>4)&1)*32+(lane&3)*8+(4*hi+((lane&15)>>2))*64;
  const char*Kbase=shm+LDS_K; bf16x8 kf[8];
  const lds_cptr shm3=(lds_cptr)shm; const lds_cptr kp0=shm3+LDS_K+hi*1024+r32*16; const lds_cptr vp0=shm3+LDS_V+((lane>>4)&1)*32+(lane&3)*8+(4*hi+((lane&15)>>2))*64;
  const int NT=nt_arg;
  const int qpos=qpos0+wid*QBLK+r32;
  DMA_K(0,0);DMA_V(0,0);DMA_K(1,SLOTB);
  bf16x8 qr[4];
  #pragma unroll
  for(int d0=0;d0<4;++d0)qr[d0]=*reinterpret_cast<const bf16x8*>(&Qw[(long)r32*DMQ+d0*16+hi*8]);
  float mhat=0.f,l_reg=0.f;f32x16 o[2];o[0]=f32x16{};o[1]=f32x16{};f32x16 negm=f32x16{};asm volatile("":"+v"(negm));
  #define CMASK(P0,P1,t) do{ if(WIN && (t)>=4) wmask(P0,P1,wlo+64*((t)-4),qpos,hi); }while(0)
  bool resc=false;
  #define START(P0,P1) do{ const float rm=rowmax(P0,P1); resc=false; \
    { const float dl=rm; mhat=fadd_s(mhat,dl); \
      _Pragma("unroll") for(int r=0;r<16;++r){P0[r]=fsub_s(P0[r],dl);P1[r]=fsub_s(P1[r],dl);} \
      _Pragma("unroll") for(int r=0;r<16;++r)negm[r]=-mhat; asm volatile("":"+v"(negm)); } \
    _Pragma("unroll") for(int r=0;r<16;++r)P0[r]=__builtin_amdgcn_exp2f(P0[r]); }while(0)
  #define RESC() do{ if(resc){ asm volatile("s_waitcnt lgkmcnt(0)":::"memory"); \
      _Pragma("unroll") for(int d_=0;d_<2;++d_) _Pragma("unroll") for(int r=0;r<16;++r)o[d_][r]*=wsf[crow(r,hi)]; } }while(0)
  f32x16 pA0,pA1,pB0,pB1;
  int sl_prev=0,sl_cur=0,sl_next=SLOTB;
  #define ROT() do{sl_prev=sl_cur;sl_cur=sl_next;sl_next=(sl_next==(NSLOT-1)*SLOTB)?0:sl_next+SLOTB;}while(0)
  DMA_K(2,2*SLOTB);
  WAIT_BAR(3);
  qkt(pA0,pA1,Kbase,qr,negm,r32,hi);asm volatile("s_nop 15\n\ts_nop 7":"+v"(pA0),"+v"(pA1));CMASK(pA0,pA1,0);
  START(pA0,pA1);
  _Pragma("unroll") for(int r=0;r<16;++r)pA1[r]=__builtin_amdgcn_exp2f(pA1[r]);
  WAIT_BAR(0);
  DMA_K(3,0);DMA_V(1,SLOTB);
  ROT();
  kload8(kf,kp0+sl_cur);
  WAIT_BAR(2);
  s16x4 vlo[8],vhi[8]; u32x4 pw0,pw1,pw2,pw3;
  #define PKW(P,B) cvtpk_s(P[B],P[B+1])
  #define PAF(k) __builtin_bit_cast(bf16x8,pw##k)
  #define VFR(i) (bf16x8){vlo[i][0],vlo[i][1],vlo[i][2],vlo[i][3],vhi[i][0],vhi[i][1],vhi[i][2],vhi[i][3]}
  #define PIN(x) asm volatile("":"+v"(x))
  #define MX3(a,b,c) __builtin_fmaxf(__builtin_fmaxf((a),(b)),(c))
  #define GAPA(MF,A0,A1,A2,A3,W0,W1,PW) do{ MF; sacc+=A0; sacc+=A1; sacc+=A2; sacc+=A3; PIN(sacc); W0; W1; PIN(PW); SBAR(); }while(0)
  #define EX(v) __builtin_amdgcn_exp2f(v)
  #define GAPB(MF,X,B) do{ MF; X[B]=EX(X[B]); X[B+1]=EX(X[B+1]); X[B+2]=EX(X[B+2]); X[B+3]=EX(X[B+3]); PIN(X); SBAR(); }while(0)
  #define VRD(i) do{ vlo[i]=vtr(vp_+(((i)>>2)*4096+((i)&3)*1024)); vhi[i]=vtr(vp_+(((i)>>2)*4096+((i)&3)*1024+512)); }while(0)
  #define KRD(G,j) do{ if(G){ kload2(kf,kp0+sl_next,j); SBAR(); } }while(0)
  #define STEP(C0,C1,P0,P1,t,GK,GV,GL) do{ SBAR(); \
    const lds_cptr vp_=vp0+sl_prev; \
    VRD(0); SBAR(); float sacc=(P0[0]+P0[1]); \
    GAPA(C0=__builtin_amdgcn_mfma_f32_32x32x16_bf16(kf[0],qr[0],negm,0,0,0), P0[2],P0[3],P0[4],P0[5],     pw0[0]=PKW(P0,0), pw0[1]=PKW(P0,2), pw0); \
    VRD(4); SBAR(); GAPA(C1=__builtin_amdgcn_mfma_f32_32x32x16_bf16(kf[1],qr[0],negm,0,0,0), P0[6],P0[7],P0[8],P0[9],     pw0[2]=PKW(P0,4), pw0[3]=PKW(P0,6), pw0); \
    VRD(1); SBAR(); GAPA(C0=__builtin_amdgcn_mfma_f32_32x32x16_bf16(kf[2],qr[1],C0,0,0,0),   P0[10],P0[11],P0[12],P0[13], pw1[0]=PKW(P0,8), pw1[1]=PKW(P0,10), pw1); \
    VRD(5); SBAR(); GAPA(C1=__builtin_amdgcn_mfma_f32_32x32x16_bf16(kf[3],qr[1],C1,0,0,0),   P0[14],P0[15],P1[0],P1[1],   pw1[2]=PKW(P0,12),pw1[3]=PKW(P0,14), pw1); \
    VRD(2); SBAR(); GAPA(C0=__builtin_amdgcn_mfma_f32_32x32x16_bf16(kf[4],qr[2],C0,0,0,0),   P1[2],P1[3],P1[4],P1[5],     pw2[0]=PKW(P1,0), pw2[1]=PKW(P1,2), pw2); \
    VRD(6); SBAR(); GAPA(C1=__builtin_amdgcn_mfma_f32_32x32x16_bf16(kf[5],qr[2],C1,0,0,0),   P1[6],P1[7],P1[8],P1[9],     pw2[2]=PKW(P1,4), pw2[3]=PKW(P1,6), pw2); \
    VRD(3); SBAR(); GAPA(C0=__builtin_amdgcn_mfma_f32_32x32x16_bf16(kf[6],qr[3],C0,0,0,0),   P1[10],P1[11],P1[12],P1[13], pw3[0]=PKW(P1,8), pw3[1]=PKW(P1,10), pw3); \
    VRD(7); SBAR(); GAPA(C1=__builtin_amdgcn_mfma_f32_32x32x16_bf16(kf[7],qr[3],C1,0,0,0),   P1[14],P1[15],0.f,0.f,       pw3[2]=PKW(P1,12),pw3[3]=PKW(P1,14), pw3); \
    l_reg+=sacc; \
    if(GK){DMA_K((t)+3,sl_cur);} if(GV){DMA_V((t)+1,sl_next);} \
    CMASK(C0,C1,t); \
    { float a=MX3(C0[0],C0[1],C1[0]),b=MX3(C0[2],C0[3],C1[1]); a=MX3(a,C1[2],C1[3]); \
      _Pragma("unroll") for(int r=4;r<16;r+=4){a=MX3(a,C0[r],C0[r+1]);b=MX3(b,C0[r+2],C0[r+3]);a=MX3(a,C1[r],C1[r+1]);b=MX3(b,C1[r+2],C1[r+3]);} \
      float rm=__builtin_fmaxf(a,b); { auto rr=__builtin_amdgcn_permlane32_swap(__float_as_uint(rm),__float_as_uint(rm),false,false); rm=__builtin_fmaxf(__uint_as_float(rr[0]),__uint_as_float(rr[1])); } \
      resc=false; \
      if(__builtin_expect(__any(rm>(float)THRL),0)){ const float dl=__builtin_fmaxf(rm,0.f); mhat+=dl; \
        _Pragma("unroll") for(int r=0;r<16;++r){C0[r]-=dl;C1[r]-=dl;} \
        _Pragma("unroll") for(int r=0;r<16;++r)negm[r]=-mhat; asm volatile("":"+v"(negm)); \
        const float f=__builtin_amdgcn_exp2f(-dl); l_reg*=f; if(hi==0)wsf[r32]=f; resc=true; } } \
    SBAR(); \
    GAPB(o[0]=__builtin_amdgcn_mfma_f32_32x32x16_bf16(PAF(0),VFR(0),o[0],0,0,0), C0,0); \
    GAPB(o[1]=__builtin_amdgcn_mfma_f32_32x32x16_bf16(PAF(0),VFR(4),o[1],0,0,0), C0,4); \
    KRD(GL,0); GAPB(o[0]=__builtin_amdgcn_mfma_f32_32x32x16_bf16(PAF(1),VFR(1),o[0],0,0,0), C0,8); \
    KRD(GL,1); GAPB(o[1]=__builtin_amdgcn_mfma_f32_32x32x16_bf16(PAF(1),VFR(5),o[1],0,0,0), C0,12); \
    KRD(GL,2); GAPB(o[0]=__builtin_amdgcn_mfma_f32_32x32x16_bf16(PAF(2),VFR(2),o[0],0,0,0), C1,0); \
    KRD(GL,3); GAPB(o[1]=__builtin_amdgcn_mfma_f32_32x32x16_bf16(PAF(2),VFR(6),o[1],0,0,0), C1,4); \
    GAPB(o[0]=__builtin_amdgcn_mfma_f32_32x32x16_bf16(PAF(3),VFR(3),o[0],0,0,0), C1,8); \
    GAPB(o[1]=__builtin_amdgcn_mfma_f32_32x32x16_bf16(PAF(3),VFR(7),o[1],0,0,0), C1,12); \
    }while(0)
  int t=1;
  #undef CMASK
  #define CMASK(P0,P1,t) do{ if(WIN && (t)>=4) wmask(P0,P1,wlo+64*((t)-4),qpos,hi); }while(0)
  for(;t+5<NT;t+=2){
    STEP(pB0,pB1,pA0,pA1,t,true,true,true);     WAIT_BAR(2); RESC(); ROT();
    STEP(pA0,pA1,pB0,pB1,t+1,true,true,true);   WAIT_BAR(2); RESC(); ROT();
  }
  #undef CMASK
  #define CMASK(P0,P1,t) do{ if(WIN && (t)>=4) wmask(P0,P1,wlo+64*((t)-4),qpos,hi); }while(0)
  #define ENDW(tt) do{ if((tt)+3<NT){WAIT_BAR(2);} else if((tt)+2<NT){WAIT_BAR(1);} else {WAIT_BAR(0);} }while(0)
  for(;t+1<NT;t+=2){
    STEP(pB0,pB1,pA0,pA1,t,(t+3<NT),(t+1<NT),(t+1<NT));       ENDW(t);   RESC(); ROT();
    STEP(pA0,pA1,pB0,pB1,t+1,(t+4<NT),(t+2<NT),(t+2<NT));     ENDW(t+1); RESC(); ROT();
  }
  STEP(pB0,pB1,pA0,pA1,NT-1,false,false,false); RESC();
  { float sacc=pB0[0]+pB0[1]; _Pragma("unroll") for(int r=2;r<16;++r)sacc+=pB0[r]; _Pragma("unroll") for(int r=0;r<16;++r)sacc+=pB1[r]; l_reg+=sacc;
    pw0=(u32x4){PKW(pB0,0),PKW(pB0,2),PKW(pB0,4),PKW(pB0,6)};pw1=(u32x4){PKW(pB0,8),PKW(pB0,10),PKW(pB0,12),PKW(pB0,14)};pw2=(u32x4){PKW(pB1,0),PKW(pB1,2),PKW(pB1,4),PKW(pB1,6)};pw3=(u32x4){PKW(pB1,8),PKW(pB1,10),PKW(pB1,12),PKW(pB1,14)};
    SBAR(); pv(o,vb0+sl_cur,PAF(0),PAF(1),PAF(2),PAF(3)); }
  #undef PKW
  #undef PAF
  #undef VFR
  #undef PIN
  #undef MX3
  #undef GAPA
  #undef GAPB
  #undef EX
  #undef VRD
  #undef KRD
  #undef STEP
  #undef ENDW
  {auto rr=__builtin_amdgcn_permlane32_swap(__float_as_uint(l_reg),__float_as_uint(l_reg),false,false);l_reg=__uint_as_float(rr[0])+__uint_as_float(rr[1]);}
  if(WIN) l_reg+=__builtin_amdgcn_exp2f(sink2-mhat);
  if(hi==0)wsf[32+r32]=l_reg;asm volatile("s_waitcnt lgkmcnt(0)":::"memory");
  float rli[16];
  #pragma unroll
  for(int r=0;r<16;++r)rli[r]=__builtin_amdgcn_rcpf(wsf[32+crow(r,hi)]);
  bf16*Ow=O+((long)qrow0+wid*QBLK)*DMQ+h*D;
  { bf16*stg=(bf16*)(shm+LDS_OST)+wid*2048;
    #pragma unroll
    for(int r=0;r<16;++r){const int orow=crow(r,hi);
      #pragma unroll
      for(int d0=0;d0<2;++d0)stg[orow*64+d0*32+r32]=(bf16)(cvtpk_s(o[d0][r]*rli[r],0.f)&0xffffu);}
    asm volatile("s_waitcnt lgkmcnt(0)":::"memory");
    #pragma unroll
    for(int i=0;i<4;++i){const int row=i*8+(lane>>3),ch=lane&7; const u32x4 v=*(const u32x4*)(stg+row*64+ch*8); ATTN_STORE16(Ow+(long)row*DMQ+ch*8,v);} }
  asm volatile("s_waitcnt lgkmcnt(0)\n\ts_barrier":::"memory");
  #undef DMA_K
  #undef TROW
  #undef DMA_V
  #undef CMASK
  #undef START
  #undef RESC
  #undef ROT
}
#undef SBAR
#undef WAIT_BAR
}

DI void phase_attention(const Ctx& P, bool dense, int j, bool with_ctx, LAS unsigned char* lds, int tid, int lane, int wave) {
    unsigned char* ws = P.ws;
    const bf16_t* Q = (const bf16_t*)(ws + WS_Q); const bf16_t* K = (const bf16_t*)(ws + WS_K); const bf16_t* V = (const bf16_t*)(ws + WS_V); bf16_t* O = (bf16_t*)(ws + WS_O);
    const int nunits = 1024 + (with_ctx ? 32 : 0);
    const float* sinkp = P.in(I_CSINK);
    const int G = gridDim.x, bx = blockIdx.x, vcu = (G % 8 == 0) ? (bx % 8) * (G / 8) + bx / 8 : bx;
    for (int u = vcu; u < nunits; u += G) {
        const bool ctxu = u >= 1024;
        const int bh = ctxu ? u - 1024 : u >> 5, qt = u & 31, b = bh >> 4, h = bh & 15, q0 = qt * 256;
        const int qrow0 = ctxu ? b * NCTX : NCTXR + b * SEQ + q0;
        if (dense) attn_dense::attn_unit<8, 256, false>(qrow0, b * KVLEN, h, h >> 2, Q, K, V, O, (char*)lds, ctxu ? 4 : KVLEN / 64, 0, 0, 0.f, tid);
        else { const int lo = q0 - 128 < 0 ? 0 : q0 - 128, hi_ = q0 + 384 > SEQ ? SEQ : q0 + 384;
            attn_dense::attn_unit<8, 128, true>(qrow0, b * KVLEN, h, h >> 3, Q, K, V, O, (char*)lds, ctxu ? 4 : 4 + (hi_ - lo) / 64, lo, q0, sinkp[h] * LOG2E, tid); }
    }
    __syncthreads();
    (void)j; (void)lane; (void)wave;
}

DI int tseq_of(int dir, bool lat, int t) { return lat ? NCTX + (dir ? (SEQ - 1 - t) : t) : (dir ? (NCTX - 1 - t) : t); }
DI void ld16h(const h16* p, float (&v)[16]) { const h16x8 a = ((const h16x8*)p)[0], b = ((const h16x8*)p)[1];
#pragma unroll
    for (int i = 0; i < 8; ++i) { v[i] = (float)a[i]; v[8 + i] = (float)b[i]; } }
DI void st16h(h16* p, const float (&v)[16]) { h16x8 a, b;
#pragma unroll
    for (int i = 0; i < 8; ++i) { a[i] = (h16)v[i]; b[i] = (h16)v[8 + i]; }
    ((h16x8*)p)[0] = a; ((h16x8*)p)[1] = b; }
constexpr int SCN_T = 32, SCN_OPB = 5 * SCN_T * 64 * 4 + SCN_T * 16 * 4  , SCN_Y0 = 2 * SCN_OPB, SCN_YB = SCN_T * 16 * 4, SCN_DUMMY = SCN_Y0 + 2 * SCN_YB, SCN_CONV = SCN_DUMMY + 4096;
struct ScanOps { f32x4 kk, w, bb, kd, r; float v; };
DI void scan_ld(ScanOps& o, const LAS float* base, int t, int kc, int rowl) {
    const LAS float* p = base + t * 64 + 4 * kc;
    o.r = *(const LAS f32x4*)p; o.w = *(const LAS f32x4*)(p + SCN_T * 64); o.kd = *(const LAS f32x4*)(p + 2 * SCN_T * 64); o.kk = *(const LAS f32x4*)(p + 3 * SCN_T * 64); o.bb = *(const LAS f32x4*)(p + 4 * SCN_T * 64);
    (void)rowl;
}
DI int scan_row(int dir, int b, int ts) { if (ts < NCTX) return b * NCTX + (dir ? NCTX - 1 - ts : ts); const int tl = ts - NCTX; return NCTXR + b * SEQ + (dir ? SEQ - 1 - tl : tl); }
DI void phase_rwkv_scan(const Ctx& P, LAS unsigned char* lds, int tid, int lane, int wave) {
    unsigned char* ws = P.ws;
    const h16* Vm = (const h16*)(ws + WS_RKV16) + 2 * ROWB; bf16_t* YS = (bf16_t*)(ws + WS_YS);
    constexpr int NCH = KVLEN / SCN_T;
    for (int u = blockIdx.x; u < 256; u += gridDim.x) {
        const int grp = u >> 2, rq = u & 3, dir = grp >> 5, b = (grp >> 4) & 1, head = grp & 15;
        __syncthreads();
#define SCN_BAR() asm volatile("s_waitcnt lgkmcnt(0)\n\ts_barrier" ::: "memory")
        if (wave >= 4) {
            const int lt = tid - 256, st = lt >> 3, sg = lt & 7, scol = head * 64 + 8 * sg;
            const h16* Rm = (const h16*)(ws + WS_RKV16); const h16* EAm = (const h16*)(ws + WS_EA16); float* BON = (float*)(ws + WS_BONUS2);
            float ckk[8], cka[8], crk[8];
            { const float* p0 = P.in(I_BKK) + scol; const float* p1 = P.in(I_BKA) + scol; const float* p2 = P.in(I_BRK) + scol;
#pragma unroll
              for (int i = 0; i < 8; ++i) { ckk[i] = p0[i]; cka[i] = p1[i]; crk[i] = p2[i]; } }
            u32x4 pre[4]; u32x4 prev; int prow = 0;
#define SCN_ISSUE(chunk) do { prow = scan_row(dir, b, (chunk) * SCN_T + st); const size_t ro = (size_t)prow * DM + scol; \
                pre[0] = *(const u32x4*)(Rm + ro); pre[1] = *(const u32x4*)(Rm + ROWB + ro); pre[2] = *(const u32x4*)(EAm + (size_t)dir * ROWB + ro); pre[3] = *(const u32x4*)(EAm + (size_t)(2 + dir) * ROWB + ro); \
                if (lt < 64) prev = *(const u32x4*)(Vm + (size_t)scan_row(dir, b, (chunk) * SCN_T + (lt >> 1)) * DM + head * 64 + rq * 16 + (lt & 1) * 8); } while (0)
#define SCN_COMMIT(bufp) do { LAS float* bf = (LAS float*)(bufp) + st * 64 + 8 * sg; \
                const h16x8 hr = __builtin_bit_cast(h16x8, pre[0]), hk = __builtin_bit_cast(h16x8, pre[1]), he = __builtin_bit_cast(h16x8, pre[2]), ha = __builtin_bit_cast(h16x8, pre[3]); \
                float kkr[8]; float n2 = 0.f; \
                _Pragma("unroll") for (int z = 0; z < 8; ++z) { kkr[z] = (float)hk[z] * ckk[z]; n2 += kkr[z] * kkr[z]; } \
                n2 = dpp_add<0xB1>(n2); n2 = dpp_add<0x4E>(n2); n2 = dpp_add<0x141>(n2); \
                const float rn = 1.0f / fmaxf(sqrtf(n2), 1e-12f); float bon = 0.f; \
                f32x4 o_r[2], o_w[2], o_kd[2], o_kk[2], o_bb[2]; \
                _Pragma("unroll") for (int z = 0; z < 8; ++z) { const float r_ = (float)hr[z], k_ = (float)hk[z], a_ = (float)ha[z]; const float kk_ = kkr[z] * rn, kd_ = k_ * (1.0f + (a_ - 1.0f) * cka[z]); \
                    o_r[z >> 2][z & 3] = r_; o_w[z >> 2][z & 3] = 1.0f - (float)he[z]; o_kd[z >> 2][z & 3] = kd_; o_kk[z >> 2][z & 3] = kk_; o_bb[z >> 2][z & 3] = -kk_ * a_; bon += r_ * kd_ * crk[z]; } \
                bon = dpp_add<0xB1>(bon); bon = dpp_add<0x4E>(bon); bon = dpp_add<0x141>(bon); \
                if (sg == 0 && rq == 0) BON[((size_t)dir * MROWS + prow) * 16 + head] = bon; \
                _Pragma("unroll") for (int q = 0; q < 2; ++q) { *(LAS f32x4*)(bf + 4 * q) = o_r[q]; *(LAS f32x4*)(bf + SCN_T * 64 + 4 * q) = o_w[q]; *(LAS f32x4*)(bf + 2 * SCN_T * 64 + 4 * q) = o_kd[q]; \
                    *(LAS f32x4*)(bf + 3 * SCN_T * 64 + 4 * q) = o_kk[q]; *(LAS f32x4*)(bf + 4 * SCN_T * 64 + 4 * q) = o_bb[q]; } \
                if (lt < 64) { const h16x8 hv = __builtin_bit_cast(h16x8, prev); LAS float* d = (LAS float*)(bufp) + 5 * SCN_T * 64 + (lt & 1) * 8 * SCN_T + (lt >> 1); \
                    _Pragma("unroll") for (int z = 0; z < 8; ++z) d[z * SCN_T] = (float)hv[z]; } } while (0)
#define SCN_YOUT(chunk) do { const LAS float* Yy = (const LAS float*)(lds + SCN_Y0 + ((chunk) & 1) * SCN_YB); const f32x2 yv = *(const LAS f32x2*)(Yy + 2 * lt); \
                *(unsigned*)(YS + (size_t)dir * ROWB + (size_t)scan_row(dir, b, (chunk) * SCN_T + (lt >> 3)) * DM + head * 64 + rq * 16 + ((2 * lt) & 15)) = cvt_pk_bf16(yv[0], yv[1]); } while (0)
            const int glw = u * 4 + (wave - 4);
            const bool conv = (gridDim.x == 256);
            LAS float* cscr = (LAS float*)(lds + SCN_CONV + (wave - 4) * 8704);
            const float* mw1 = P.in(I_MW1); const float* mw3 = P.in(I_MW3); const float* mw2 = P.in(I_MW2);
            float tv[32]; MoeItem mi; int mldt = 0;
            SCN_ISSUE(0); SCN_COMMIT(lds); SCN_ISSUE(1);
            if (conv) { mi = moe_item_decode(mw1, mw3, mw2, ws, N_MOE_PRO + glw, lane, mldt); moe_item_load(mi, tv); }
            SCN_BAR();
            for (int ch = 0; ch < NCH; ++ch) {
                if (ch + 1 < NCH) SCN_COMMIT(lds + ((ch + 1) & 1) * SCN_OPB);
                if (ch > 0) SCN_YOUT(ch - 1);
                if (ch + 2 < NCH) SCN_ISSUE(ch + 2);
                if (conv && ch < 108) { moe_item_store(mi, mldt, tv, cscr, lane);
                    if (ch + 1 < 108) { mi = moe_item_decode(mw1, mw3, mw2, ws, N_MOE_PRO + glw + 1024 * (ch + 1), lane, mldt); moe_item_load(mi, tv); } }
                SCN_BAR();
            }
            SCN_YOUT(NCH - 1);
#undef SCN_ISSUE
#undef SCN_COMMIT
#undef SCN_YOUT
        } else {
            const int rowl = 4 * wave + (lane >> 4), kc = lane & 15;
            f32x2 S01 = (f32x2){0.f, 0.f}, S23 = (f32x2){0.f, 0.f};
            const int yoff = (kc < 4) ? kc * 64 + rowl * 4 : (SCN_DUMMY - SCN_Y0) + lane * 4, ystep = (kc < 4) ? 64 : 0;
            SCN_BAR();
            for (int ch = 0; ch < NCH; ++ch) {
                const LAS float* base = (const LAS float*)(lds + (ch & 1) * SCN_OPB);
                LAS unsigned char* yb = lds + SCN_Y0 + (ch & 1) * SCN_YB;
                ScanOps cur, nxt; scan_ld(cur, base, 0, kc, rowl);
                const LAS float* vrow = base + 5 * SCN_T * 64 + rowl * SCN_T;
                f32x4 vq = *(const LAS f32x4*)vrow, vqn = vq;
                float yq[4] = {0.f, 0.f, 0.f, 0.f};
#pragma unroll
                for (int t = 0; t < SCN_T; ++t) {
                    if (t + 1 < SCN_T) { scan_ld(nxt, base, t + 1, kc, rowl); if (((t + 1) & 3) == 0) vqn = *(const LAS f32x4*)(vrow + t + 1); }
                    __builtin_amdgcn_sched_barrier(0);
                    cur.v = vq[t & 3];
                    f32x2 p = S01 * (f32x2){cur.kk[0], cur.kk[1]}; p = S23 * (f32x2){cur.kk[2], cur.kk[3]} + p;
                    const float sa = allreduce16(p[0] + p[1]);
                    if (t > 0 && (t & 3) == 0) { const float y = merge4_reduce16(yq[0], yq[1], yq[2], yq[3], lane); *(LAS float*)(yb + (t - 4) * ystep + yoff) = y; }
                    const f32x2 vv = (f32x2){cur.v, cur.v};
                    const f32x2 t01 = S01 * (f32x2){cur.w[0], cur.w[1]} + (f32x2){cur.kd[0], cur.kd[1]} * vv, t23 = S23 * (f32x2){cur.w[2], cur.w[3]} + (f32x2){cur.kd[2], cur.kd[3]} * vv;
                    const f32x2 sa2 = (f32x2){sa, sa};
                    S01 = (f32x2){cur.bb[0], cur.bb[1]} * sa2 + t01; S23 = (f32x2){cur.bb[2], cur.bb[3]} * sa2 + t23;
                    f32x2 q = S01 * (f32x2){cur.r[0], cur.r[1]}; q = S23 * (f32x2){cur.r[2], cur.r[3]} + q;
                    yq[t & 3] = q[0] + q[1];
                    cur = nxt; if (((t + 1) & 3) == 0) vq = vqn;
                    __builtin_amdgcn_sched_barrier(0);
                }
                { const float y = merge4_reduce16(yq[0], yq[1], yq[2], yq[3], lane); *(LAS float*)(yb + (SCN_T - 4) * ystep + yoff) = y; }
                SCN_BAR();
            }
        }
    }
}
DI void phase_rwkv_out(const Ctx& P, int lane, int gw, int NGW) {
    unsigned char* ws = P.ws;
    const bf16_t* YS = (const bf16_t*)(ws + WS_YS); const h16* Vm = (const h16*)(ws + WS_RKV16) + 2 * ROWB; const bf16_t* Gm = (const bf16_t*)(ws + WS_G); const float* BONUS = (const float*)(ws + WS_BONUS2);
    bf16_t* HA0 = (bf16_t*)(ws + WS_HA0);
    const int c0 = 16 * lane, head = lane >> 2;
    const float* lnw = P.in(I_BLNW) + c0; const float* lnb = P.in(I_BLNB) + c0;
    for (int row = gw; row < MROWS; row += NGW) {
        float y[16], v[16];
#pragma unroll
        for (int q = 0; q < 2; ++q) { const u32x4 a = ((const u32x4*)(YS + (size_t)row * DM + c0))[q], b = ((const u32x4*)(YS + ROWB + (size_t)row * DM + c0))[q];
#pragma unroll
            for (int z = 0; z < 4; ++z) { y[8 * q + 2 * z] = bf_lo(a[z]) + bf_lo(b[z]); y[8 * q + 2 * z + 1] = bf_hi(a[z]) + bf_hi(b[z]); } }
        float s = 0.f;
#pragma unroll
        for (int i = 0; i < 16; ++i) s += y[i];
        s += __shfl_xor(s, 1); s += __shfl_xor(s, 2);
        const float mean = s * (1.0f / 64.0f);
        float q2 = 0.f;
#pragma unroll
        for (int i = 0; i < 16; ++i) { y[i] -= mean; q2 += y[i] * y[i]; }
        q2 += __shfl_xor(q2, 1); q2 += __shfl_xor(q2, 2);
        const float rstd = rsqrtf(q2 * (1.0f / 64.0f) + LN_X_EPS);
        ld16h(Vm + (size_t)row * DM + c0, v);
        const float bon = BONUS[(size_t)row * 16 + head] + BONUS[((size_t)MROWS + row) * 16 + head];
        const u32x4 g0 = ((const u32x4*)(Gm + (size_t)row * DM + c0))[0], g1 = ((const u32x4*)(Gm + (size_t)row * DM + c0))[1];
        float g[16];
        g[0] = bf_lo(g0.x); g[1] = bf_hi(g0.x); g[2] = bf_lo(g0.y); g[3] = bf_hi(g0.y); g[4] = bf_lo(g0.z); g[5] = bf_hi(g0.z); g[6] = bf_lo(g0.w); g[7] = bf_hi(g0.w);
        g[8] = bf_lo(g1.x); g[9] = bf_hi(g1.x); g[10] = bf_lo(g1.y); g[11] = bf_hi(g1.y); g[12] = bf_lo(g1.z); g[13] = bf_hi(g1.z); g[14] = bf_lo(g1.w); g[15] = bf_hi(g1.w);
        float o[16];
#pragma unroll
        for (int i = 0; i < 16; ++i) o[i] = (y[i] * rstd * lnw[i] + lnb[i] + bon * v[i]) * g[i];
        u32x4 w0, w1;
        w0.x = cvt_pk_bf16(o[0], o[1]); w0.y = cvt_pk_bf16(o[2], o[3]); w0.z = cvt_pk_bf16(o[4], o[5]); w0.w = cvt_pk_bf16(o[6], o[7]);
        w1.x = cvt_pk_bf16(o[8], o[9]); w1.y = cvt_pk_bf16(o[10], o[11]); w1.z = cvt_pk_bf16(o[12], o[13]); w1.w = cvt_pk_bf16(o[14], o[15]);
        ((u32x4*)(HA0 + (size_t)row * DM + c0))[0] = w0; ((u32x4*)(HA0 + (size_t)row * DM + c0))[1] = w1;
    }
}

#define FRESH() do { tid = threadIdx.x; asm volatile("" : "+v"(tid)); lane = tid & 63; wave = __builtin_amdgcn_readfirstlane(tid >> 6); gw = bx * 8 + wave; } while (0)
#define GRID_BAR() do { xcd_barrier_fn(bar.bar, bar.x, bar.st, tid); FRESH(); } while (0)
template <int L> DI void run_layer(const Ctx& P, LAS unsigned char* lds, const XcdBarrier& bar) {
    int tid, lane, wave, gw;
    const int G = gridDim.x, bx = blockIdx.x, NGW = G * 8;
    unsigned char* ws = P.ws;
    FRESH();

        constexpr int l = L; constexpr int kind = L % 3, j = L / 3; constexpr bool last = (L == DEPTH - 1);
        phase_norm1(P, l, kind == 1, lds, tid, lane, gw, NGW);
        GRID_BAR();
        if (kind != 1) {
            {
                const bool dense = kind == 0;
                SchedDense S; S.A = (const char*)(ws + WS_HA0); S.B = dense ? (const char*)(ws + WS_WAQKV) + (size_t)j * 1536 * 1024 * 2 : (const char*)(ws + WS_WCQKV);
                S.nN = dense ? 6 : 5; S.nM = 66; S.G = G; S.c = bx; S.pm0 = 0; S.tileb = (size_t)256 * 1024 * 2;
                EpiQKV E; E.Q = (bf16_t*)(ws + WS_Q); E.K = (bf16_t*)(ws + WS_K); E.V = (bf16_t*)(ws + WS_V); E.dense = dense ? 1 : 0;
                E.qgain = P.in(I_AQG) + j * 64; E.kgain = P.in(I_AKG) + j * 64; E.RT = (const float*)(ws + WS_ROPE); E.xch = (LAS float*)(lds + 135168);
                pg8::gemm_phase(lds, 1024, S, E, tid);
            }
            GRID_BAR();
            phase_attention(P, kind == 0, j, !last, lds, tid, lane, wave);
            GRID_BAR();
        } else {
            {   SchedRkvl S; S.MIX = (const char*)(ws + WS_MIX); S.B = (const char*)(ws + WS_WBRKVL); S.G = G; S.c = bx;
                EpiRkvl E; E.RKV = (h16*)(ws + WS_RKV16); E.TWA = (bf16_t*)(ws + WS_TWA); E.TG = (bf16_t*)(ws + WS_TG);
                pg8::gemm_phase(lds, 1024, S, E, tid);
            }
            GRID_BAR();
            {   SchedLora2 S; S.TWA = (const char*)(ws + WS_TWA); S.TG = (const char*)(ws + WS_TG); S.B = (const char*)(ws + WS_WBL2); S.G = G; S.c = bx;
                EpiLora2 E; E.EA = (h16*)(ws + WS_EA16); E.Gm = (bf16_t*)(ws + WS_G); E.w0 = P.in(I_BW0); E.a0 = P.in(I_BA0);
                int k128 = 128; asm volatile("" : "+s"(k128));
                pg8::gemm_phase(lds, k128, S, E, tid, 256);
            }
            GRID_BAR();
            phase_rwkv_scan(P, lds, tid, lane, wave);
            GRID_BAR();
            phase_rwkv_out(P, lane, gw, NGW);
            GRID_BAR();
        }
        {
            SchedDense S; S.A = kind == 1 ? (const char*)(ws + WS_HA0) : (const char*)(ws + WS_O);
            S.B = kind == 0 ? (const char*)(ws + WS_WAO) + (size_t)j * 1024 * 1024 * 2 : kind == 1 ? (const char*)(ws + WS_WBO) : (const char*)(ws + WS_WCO);
            S.nN = 4; S.pm0 = 2; S.nM = 64; S.G = G; S.c = bx; S.tileb = (size_t)256 * 1024 * 2;
            EpiResid E; E.X = (bf16_t*)(ws + xres_of(l)); E.gate_l = (const float*)(ws + WS_MOD) + (size_t)l * 3 * 6 * 1024 + 2 * 1024; E.scale = 1.0f;
            pg8::gemm_phase(lds, 1024, S, E, tid);
            if (!last) {
                SchedCtxSplit S2; S2.A = S.A; S2.B = S.B; S2.c = bx;
                EpiPartial E2; E2.PART = (float*)(ws + WS_PART);
                int k128 = 128; asm volatile("" : "+s"(k128));
                pg8::gemm_phase(lds, k128, S2, E2, tid, 1024);
            }
        }
        GRID_BAR();
        phase_norm2_router(P, l, lds, tid, lane, gw, NGW);
        GRID_BAR();
        {
        {   const int nblk = moe_tables(P, l, lds, tid);
            SchedMoeG S; S.A = (const char*)(ws + WS_HA0); S.B = (const char*)(ws + WS_WM13) + (size_t)l * 32 * 1536 * 1024 * 2; S.nM = nblk; S.G = G; S.c = bx;
            S.blk_e = (const LAS int*)(lds + LDS_MISC + MISC_BLKE); S.ltok = (const LAS int*)(lds + LDS_LTOK);
            {
                const int* LIST = (const int*)(ws + WS_LIST); LAS int* lt_ = (LAS int*)(lds + LDS_LTOK); Unit u;
                const LAS int* start = (const LAS int*)(lds + LDS_MISC + MISC_START); const LAS int* cnt_l = (const LAS int*)(lds + LDS_MISC + MISC_CNTL);
                for (int i = 0; i < 4; ++i) { if (!S.next(i, u)) break;
                    if (tid < 256) { const int e = S.blk_e[u.pm], pos = u.pm * 256 - start[e] + tid; lt_[i * 256 + tid] = pos < cnt_l[e] ? LIST[(size_t)e * MROWS + pos] : 0; } }
                __syncthreads();
            }
            EpiMoe1 E; E.H = (bf16_t*)(ws + WS_HID);
            pg8::gemm_phase(lds, 1024, S, E, tid);
        }
        GRID_BAR();
        {   const int nblk = moe_tables(P, l, lds, tid);
            SchedMoe S; S.A = (const char*)(ws + WS_HID); S.B = (const char*)(ws + WS_WM2) + (size_t)l * 32 * 1024 * 768 * 2; S.nN = 4; S.nM = nblk; S.G = G; S.c = bx;
            S.atile = (size_t)256 * 768 * 2; S.btile = (size_t)256 * 768 * 2; S.bexp = (size_t)1024 * 768 * 2; S.blk_e = (const LAS int*)(lds + LDS_MISC + MISC_BLKE);
            EpiMoe2 E; E.Y = (bf16_t*)(ws + WS_YASG);
            pg8::gemm_phase(lds, 768, S, E, tid);
        }
        GRID_BAR();
        }
    }
__global__ void __launch_bounds__(512, 2) hybrid_fwd(Params KP) {
    extern __shared__ __attribute__((aligned(16))) unsigned char lds_raw[];
    LAS unsigned char* lds = (LAS unsigned char*)lds_raw;
    int tid, lane, wave, gw;
    const int G = gridDim.x, bx = blockIdx.x, NGW = G * 8;
    FRESH();
    unsigned char* ws = KP.ws;
    for (int i = tid; i < (LDS_BYTES - LDS_MISC) / 4; i += 512) ((LAS unsigned*)(lds + LDS_MISC))[i] = 0u;
    __syncthreads();
    if (tid < N_IN) ((LAS unsigned long long*)(lds + LDS_MISC + MISC_PTAB))[tid] = (unsigned long long)KP.in[tid];
    __syncthreads();
    Ctx P; P.tab = (const volatile LAS unsigned long long*)(lds + LDS_MISC + MISC_PTAB); P.ws = ws; P.out = KP.out;
    const XcdBarrier bar = xcd_barrier_post((unsigned*)(ws + WS_CTL) + CW_BAR, (volatile LAS unsigned*)(lds + LDS_MISC + MISC_BAR));

    phase_prologue(P, lds, tid, lane, wave);
    GRID_BAR();

    run_layer<0>(P, lds, bar); run_layer<1>(P, lds, bar); run_layer<2>(P, lds, bar); run_layer<3>(P, lds, bar);
    FRESH();
    phase_final(P, lds, tid, lane, gw, NGW);
}

extern "C" void kernel_launch(void* const* d_in, const int* in_sizes, int n_in, void* d_out, int out_size, void* d_ws, size_t ws_size, hipStream_t stream) {
    static int grid = 0;
    if (grid == 0) {
        if (n_in != N_IN || out_size != NB * SEQ * DM || ws_size < WS_END) { fprintf(stderr, "kernel_launch: unexpected problem (n_in %d, out %d, ws %zu < %zu); nothing launched\n", n_in, out_size, ws_size, (size_t)WS_END); grid = -1; return; }
        int dev = 0, cus = 0, per_cu = 0;
        if (hipGetDevice(&dev) != hipSuccess || hipDeviceGetAttribute(&cus, hipDeviceAttributeMultiprocessorCount, dev) != hipSuccess) { grid = -1; return; }
        if (hipFuncSetAttribute((const void*)hybrid_fwd, hipFuncAttributeMaxDynamicSharedMemorySize, LDS_BYTES) != hipSuccess) { fprintf(stderr, "kernel_launch: hipFuncSetAttribute failed\n"); grid = -1; return; }
        if (hipOccupancyMaxActiveBlocksPerMultiprocessor(&per_cu, (const void*)hybrid_fwd, 512, LDS_BYTES) != hipSuccess || per_cu < 1) { fprintf(stderr, "kernel_launch: occupancy query says %d\n", per_cu); }
        (void)hipGetLastError();
        grid = cus;
    }
    if (grid < 0) return;
    (void)in_sizes;
    if (hipMemsetAsync((char*)d_ws + WS_CTL, 0, CTL_ZERO_BYTES, stream) != hipSuccess) { fprintf(stderr, "kernel_launch: memset failed\n"); return; }
    Params p{};
    for (int i = 0; i < N_IN; ++i) p.in[i] = (const float*)d_in[i];
    p.out = (float*)d_out; p.ws = (unsigned char*)d_ws;
    hipLaunchKernelGGL(hybrid_fwd, dim3(grid), dim3(512), LDS_BYTES, stream, p);
    const hipError_t le = hipPeekAtLastError();
    if (le != hipSuccess) fprintf(stderr, "kernel_launch: launch failed: %s\n", hipGetErrorName(le));
}
```

```cpp
#include <hip/hip_runtime.h>
#include <cstdio>
#include <cstdint>

#define DI __device__ __forceinline__
#define LAS __attribute__((address_space(3)))
typedef unsigned short bf16_t;
typedef short bf16x8 __attribute__((ext_vector_type(8)));
typedef short s16x4 __attribute__((ext_vector_type(4)));
typedef float f32x2 __attribute__((ext_vector_type(2)));
typedef float f32x4 __attribute__((ext_vector_type(4)));
typedef float f32x16 __attribute__((ext_vector_type(16)));
typedef unsigned u32x2 __attribute__((ext_vector_type(2)));
typedef unsigned u32x4 __attribute__((ext_vector_type(4)));
typedef _Float16 h16;
typedef _Float16 h16x8 __attribute__((ext_vector_type(8)));
typedef _Float16 h16x4 __attribute__((ext_vector_type(4)));
typedef __bf16 bf16x2_t __attribute__((ext_vector_type(2)));

constexpr int DM = 1024, NB = 2, SEQ = 8192, NCTX = 256, NCTXR = NB * NCTX, MROWS = NCTXR + NB * SEQ, KVLEN = NCTX + SEQ;
constexpr int NEXP = 32, DEXP = 768, MOE_MAXBLK = 164, MOE_ROWS = MOE_MAXBLK * 256;
constexpr int DEPTH = 4;
constexpr float NORM_EPS = 1e-6f, LN_X_EPS = 64e-5f;
constexpr float C2 = 0.125f * 1.4426950408889634f;
constexpr float LOG2E = 1.4426950408889634f;

enum { I_X = 0, I_C, I_CTX, I_CCTX, I_MODW, I_MODB, I_N1G, I_N2G, I_AQKV, I_AO, I_AQG, I_AKG, I_BMU, I_BWR, I_BWK, I_BWV, I_BWO, I_BW0, I_BW1, I_BW2,
       I_BA0, I_BA1, I_BA2, I_BG1, I_BG2, I_BKK, I_BKA, I_BRK, I_BLNW, I_BLNB, I_CQKV, I_CO, I_CSINK, I_MWG, I_MBG, I_MWE, I_MBE, I_MW1, I_MW3, I_MW2, I_FG, N_IN };

constexpr size_t MiB = 1ull << 20;
constexpr size_t WS_CTL = 0, CTL_ZERO_BYTES = 1 * MiB;
constexpr size_t WS_MOD = 1 * MiB;
constexpr size_t WS_ROPE = WS_MOD + 512 * 1024;
constexpr size_t WS_WR = 2 * MiB;
constexpr size_t WS_TOK = 3 * MiB;
constexpr size_t TOK_STRIDE = (size_t)MROWS * 8;
constexpr size_t WS_ROWTOK = WS_TOK + 4 * TOK_STRIDE;
constexpr size_t WS_BONUS = 4 * MiB;
constexpr size_t WS_WAQKV = 6 * MiB;
constexpr size_t WS_WAO = 12 * MiB;
constexpr size_t WS_WCQKV = 16 * MiB;
constexpr size_t WS_WCO = 19 * MiB;
constexpr size_t WS_WBRKVL = 21 * MiB;
constexpr size_t WS_WBO = 29 * MiB;
constexpr size_t WS_WBL2 = 31 * MiB;
constexpr size_t WS_WM13 = 34 * MiB;
constexpr size_t WS_WM2 = 418 * MiB;
constexpr size_t WS_XRES = 610 * MiB;
constexpr size_t WS_HA0 = 676 * MiB;
constexpr size_t WS_A = 709 * MiB;
constexpr size_t WS_B = 907 * MiB;
constexpr size_t WS_C = 1023 * MiB;
constexpr size_t WS_XRES2 = 1353 * MiB;
constexpr size_t WS_PART = 1419 * MiB;
constexpr size_t WS_BONUS2 = 1435 * MiB;
constexpr size_t WS_LIST = 1438 * MiB;
constexpr size_t WS_END = 1441 * MiB;
constexpr size_t ROWB = (size_t)MROWS * DM;
constexpr size_t WS_MIX = WS_A;
constexpr size_t WS_EA16 = WS_A;
constexpr size_t WS_G = WS_A + 132 * MiB;
constexpr size_t WS_YS = WS_C;
constexpr size_t WS_Q = WS_A;
constexpr size_t WS_O = WS_A + 33 * MiB;
constexpr size_t WS_K = WS_A + 66 * MiB;
constexpr size_t WS_V = WS_A + 75 * MiB;
constexpr size_t WS_RKV16 = WS_B;
constexpr size_t WS_TWA = WS_B + 99 * MiB;
constexpr size_t WS_TG = WS_B + 99 * MiB + (size_t)MROWS * 256 * 2;
constexpr size_t WS_SC = WS_C;
constexpr size_t WS_ASORT = WS_C;
constexpr size_t WS_HID = WS_C + 82 * MiB;
constexpr size_t WS_YASG = WS_C + 144 * MiB;
static_assert(WS_TG + (size_t)MROWS * 256 * 2 <= WS_C && WS_YASG + (size_t)MOE_ROWS * 1024 * 2 <= WS_END && (size_t)64 * KVLEN * 640 <= 330 * MiB, "ws map");
static_assert(WS_WM13 + (size_t)128 * 1536 * 1024 * 2 <= WS_WM2 && WS_WM2 + (size_t)128 * 1024 * 768 * 2 <= WS_XRES, "ws map 2");
constexpr int CW_BAR = 4096;
constexpr int CW_CNT = 16384, CNT_STRIDE = 32;

constexpr int LDS_MISC = 147456;
constexpr int LDS_BYTES = LDS_MISC + 4096;
constexpr int MISC_BAR = 0, MISC_START = 64, MISC_BLKE = 256, MISC_PTAB = 1024, MISC_CNTL = 1536;

DI size_t xres_of(int l) { return l == 1 ? WS_XRES2 : WS_XRES; }
struct Params { const float* in[N_IN]; float* out; unsigned char* ws; };
struct Ctx { const volatile LAS unsigned long long* tab; unsigned char* ws; float* out;
    __device__ __forceinline__ const float* in(int i) const { const unsigned long long v = tab[i];
        const unsigned lo = __builtin_amdgcn_readfirstlane((unsigned)v), hi = __builtin_amdgcn_readfirstlane((unsigned)(v >> 32));
        return (const float*)(const __attribute__((address_space(1))) float*)(((unsigned long long)hi << 32) | lo); } };

DI unsigned cvt_pk_bf16(float lo, float hi) { f32x2 v = {lo, hi}; bf16x2_t b = __builtin_convertvector(v, bf16x2_t); return __builtin_bit_cast(unsigned, b); }
DI float bf_lo(unsigned u) { return __builtin_bit_cast(float, u << 16); }
DI float bf_hi(unsigned u) { return __builtin_bit_cast(float, u & 0xffff0000u); }
DI float wave_sum(float v) {
#pragma unroll
    for (int o = 1; o < 64; o <<= 1) v += __shfl_xor(v, o);
    return v;
}
template <int CTRL> DI float dpp_add(float x) { const int xi = __builtin_bit_cast(int, x); const int yi = __builtin_amdgcn_update_dpp(0, xi, CTRL, 0xF, 0xF, true); return x + __builtin_bit_cast(float, yi); }
DI float allreduce16(float x) { x = dpp_add<0xB1>(x); x = dpp_add<0x4E>(x); x = dpp_add<0x141>(x); x = dpp_add<0x140>(x); return x; }
template <int CTRL> DI float dpp_mov(float x) { return __builtin_bit_cast(float, __builtin_amdgcn_update_dpp(0, __builtin_bit_cast(int, x), CTRL, 0xF, 0xF, true)); }
DI float merge4_reduce16(float a, float b, float c, float d, int lane) {
    const bool b0 = (lane & 1) != 0, b1 = (lane & 2) != 0;
    const float x = (b0 ? b : a) + dpp_mov<0xB1>(b0 ? a : b);
    const float z = (b0 ? d : c) + dpp_mov<0xB1>(b0 ? c : d);
    float w = (b1 ? z : x) + dpp_mov<0x4E>(b1 ? x : z);
    w += dpp_mov<0x124>(w); w += dpp_mov<0x128>(w);
    return w;
}
DI float wave_sum_dpp(float x) { x = allreduce16(x);
    const float a = __builtin_bit_cast(float, __builtin_amdgcn_readlane(__builtin_bit_cast(int, x), 0)), b = __builtin_bit_cast(float, __builtin_amdgcn_readlane(__builtin_bit_cast(int, x), 16)),
                c = __builtin_bit_cast(float, __builtin_amdgcn_readlane(__builtin_bit_cast(int, x), 32)), d = __builtin_bit_cast(float, __builtin_amdgcn_readlane(__builtin_bit_cast(int, x), 48));
    return (a + b) + (c + d); }
DI int vec_of_row(int row) { return row < NCTXR ? 2 : ((row - NCTXR) >> 13); }
DI int kvrow_of(int row) { if (row < NCTXR) return (row >> 8) * KVLEN + (row & 255); const int r = row - NCTXR; return (r >> 13) * KVLEN + NCTX + (r & 8191); }
DI float silu_f(float x) { return x * __builtin_amdgcn_rcpf(1.f + __expf(-x)); }
DI float sigmoid_f(float x) { return __builtin_amdgcn_rcpf(1.f + __expf(-x)); }

#define XB_TMO      128
#define XB_XCNT(j)  (256  + 64 * (j))
#define XB_XSUB(j)  (1280 + 64 * (j))
#define XB_XGEN(j)  (2304 + 64 * (j))
#define XB_TOP      3328
#define XB_TOPGEN   3392
#define XCD_BAR_WORDS 3456
#define XB_SPIN_CAP (1u << 20)
DI unsigned xb_ld(unsigned* p)              { return __hip_atomic_load(p, __ATOMIC_RELAXED, __HIP_MEMORY_SCOPE_AGENT); }
DI unsigned xb_add(unsigned* p, unsigned v) { return __hip_atomic_fetch_add(p, v, __ATOMIC_RELAXED, __HIP_MEMORY_SCOPE_AGENT); }
DI unsigned xb_xcc_id() { return (unsigned)__builtin_amdgcn_s_getreg((3 << 11) | 20) & 0xFu; }
#define XB_SPIN(cond, bar) do { unsigned _sp = 0; while (cond) { __builtin_amdgcn_s_sleep(1); \
    if ((++_sp & 255u) == 0u) { if (xb_ld(&(bar)[XB_TMO])) break; if (_sp > XB_SPIN_CAP) { atomicAdd(&(bar)[XB_TMO], 1u); break; } } } } while (0)
struct XcdBarrier { unsigned* bar; unsigned x; volatile LAS unsigned* st; };
DI XcdBarrier xcd_barrier_post(unsigned* bar, volatile LAS unsigned* st) {
    XcdBarrier b; b.bar = bar; b.x = xb_xcc_id(); b.st = st;
    if (threadIdx.x == 0) (void)xb_add(&bar[XB_XCNT(b.x)], 1u);
    return b;
}
DI void xcd_barrier_complete(unsigned* bar, unsigned x, unsigned& nloc, unsigned& nx) {
    const unsigned G = gridDim.x * gridDim.y * gridDim.z;
    unsigned sum, cnt, mine, sp = 0u;
    for (;;) {
        sum = 0u; cnt = 0u; mine = 0u;
#pragma unroll
        for (unsigned j = 0; j < 16; ++j) { const unsigned c = xb_ld(&bar[XB_XCNT(j)]); sum += c; cnt += (c > 0u) ? 1u : 0u; mine = (j == x) ? c : mine; }
        if (sum == G) break;
        __builtin_amdgcn_s_sleep(1);
        if ((++sp & 255u) == 0u) { if (xb_ld(&bar[XB_TMO])) break; if (sp > XB_SPIN_CAP) { atomicAdd(&bar[XB_TMO], 1u); break; } }
    }
    nloc = mine > 0u ? mine : 1u; nx = cnt > 0u ? cnt : 1u;
}
__device__ __attribute__((noinline)) void xcd_barrier_fn(unsigned* bar_, unsigned x_, volatile LAS unsigned* st_, int tid_) {
    XcdBarrier b; b.bar = bar_; b.x = x_; b.st = st_;
    asm volatile("s_waitcnt vmcnt(0)" ::: "memory");
    __syncthreads();
    if (tid_ == 0) {
        unsigned* bar = b.bar;
        __builtin_amdgcn_s_waitcnt(0);
        unsigned nloc = b.st[0], nx = b.st[1];
        if (nloc == 0u) { xcd_barrier_complete(bar, b.x, nloc, nx); b.st[0] = nloc; b.st[1] = nx; }
        const unsigned old = xb_add(&bar[XB_XSUB(b.x)], 1u);
        const unsigned gen = old / nloc;
        if (old + 1u == (gen + 1u) * nloc) {
            __builtin_amdgcn_fence(__ATOMIC_RELEASE, "agent");
            asm volatile("s_waitcnt vmcnt(0)" ::: "memory");
            const unsigned og = xb_add(&bar[XB_TOP], 1u);
            const unsigned tg = og / nx;
            if (og + 1u == (tg + 1u) * nx) xb_add(&bar[XB_TOPGEN], 1u);
            else XB_SPIN(xb_ld(&bar[XB_TOPGEN]) == tg, bar);
            __builtin_amdgcn_fence(__ATOMIC_ACQUIRE, "agent");
            xb_add(&bar[XB_XGEN(b.x)], 1u);
            asm volatile("s_waitcnt vmcnt(0)" ::: "memory");
        } else {
            XB_SPIN(xb_ld(&bar[XB_XGEN(b.x)]) == gen, bar);
            __builtin_amdgcn_fence(__ATOMIC_ACQUIRE, "agent");
            asm volatile("s_waitcnt vmcnt(0)" ::: "memory");
        }
    }
    __syncthreads();
}

namespace pg8 {
constexpr int BM = 256, BK = 64, HALF = 128, HTB = HALF * BK * 2;
DI int lds_byte(int r, int c) { const int st = (r >> 4) * 2 + (c >> 5), rr = r & 15, cc = c & 31, ob = rr * 64 + cc * 2; return st * 1024 + (ob ^ (((ob >> 9) & 1) << 5)); }
DI void stage_rc(int b, int& R, int& C) { const int st = b / 1024, sb = b % 1024, swz = sb ^ (((sb >> 9) & 1) << 5); R = (st >> 1) * 16 + swz / 64; C = (st & 1) * 32 + (swz % 64) / 2; }
DI int perm32(int rho) { const int n = rho >> 4, i = rho & 15; return 8 * (i >> 2) + 4 * n + (i & 3); }
struct Unit { int pm, pn; const char* A; const char* B; int tok; int half; };

template <class Epi, class Sched>
DI void gemm_phase(LAS unsigned char* lds, const int K, const Sched& S, const Epi& E, const int tid, const int ld_ = 0) {
    const int ld = ld_ ? ld_ : K;
    const int wid = __builtin_amdgcn_readfirstlane(tid >> 6), lane = tid & 63, wr = wid >> 2, wc = wid & 3, fr = lane & 15, fq = lane >> 4;
    const int nt = K / BK;
    unsigned voffA[2], voffB[2];
#pragma unroll
    for (int i = 0; i < 2; ++i) { int R, C; stage_rc(tid * 16 + i * 8192, R, C); const int Rb = Epi::PERM ? ((R & ~31) + perm32(R & 31)) : R;
        voffA[i] = (unsigned)(R * ld + C) * 2u; voffB[i] = (unsigned)(Rb * ld + C) * 2u; }
    constexpr bool GA = Sched::GATHER;
    unsigned oA[2][2], nO[2][2]; int gR[2], gC2[2];
#pragma unroll
    for (int i = 0; i < 2; ++i) { int R, C; stage_rc(tid * 16 + i * 8192, R, C); gR[i] = R; gC2[i] = C * 2; oA[0][i] = oA[1][i] = nO[0][i] = nO[1][i] = 0u; }
#define PG8_TOKOFF(dst, u) do { _Pragma("unroll") for (int _h = 0; _h < 2; ++_h) _Pragma("unroll") for (int _i = 0; _i < 2; ++_i) dst[_h][_i] = (unsigned)S.tokrow((u).tok + _h * 128 + gR[_i]) * (unsigned)(ld * 2) + (unsigned)gC2[_i]; } while (0)
    const size_t kstep = (size_t)(BK * 2);
    const size_t hstep = (size_t)HALF * ld * 2;
    const unsigned ldsw = (unsigned)wid * 1024u;
    const int aoff = lds_byte(wr * 64 + fr, fq * 8), boff = lds_byte(wc * 32 + fr, fq * 8);
#define PG8_SA(b, h) (((b) * 2 + (h)) * HTB)
#define PG8_SB(b, h) ((4 + (b) * 2 + (h)) * HTB)
#define PG8_STAGE(bufoff, gbase, voff) do { _Pragma("unroll") for (int _i = 0; _i < 2; ++_i) \
        __builtin_amdgcn_global_load_lds((const unsigned*)((const char*)(gbase) + (voff)[_i]), (LAS unsigned*)(lds + (bufoff) + ldsw + _i * 8192), 16, 0, 0); } while (0)
#define PG8_STAGE_A(bufoff, kptr, h, OFF) do { if constexpr (GA) PG8_STAGE(bufoff, kptr, OFF[h]); else PG8_STAGE(bufoff, (kptr) + (h) * hstep, voffA); } while (0)
#define PG8_LDA(dst, b, h) do { _Pragma("unroll") for (int m = 0; m < 4; ++m) _Pragma("unroll") for (int k = 0; k < 2; ++k) dst[m][k] = *(const LAS bf16x8*)(lds + PG8_SA(b, h) + aoff + m * 2048 + k * 1024); } while (0)
#define PG8_LDB(dst, b, h) do { _Pragma("unroll") for (int n = 0; n < 2; ++n) _Pragma("unroll") for (int k = 0; k < 2; ++k) dst[n][k] = *(const LAS bf16x8*)(lds + PG8_SB(b, h) + boff + n * 2048 + k * 1024); } while (0)
#define PG8_MMA(ai, bj, At, Bt) do { __builtin_amdgcn_s_setprio(1); _Pragma("unroll") for (int m = 0; m < 4; ++m) _Pragma("unroll") for (int n = 0; n < 2; ++n) _Pragma("unroll") for (int k = 0; k < 2; ++k) \
        acc[ai][bj][m][n] = __builtin_amdgcn_mfma_f32_16x16x32_bf16(Bt[n][k], At[m][k], acc[ai][bj][m][n], 0, 0, 0); __builtin_amdgcn_s_setprio(0); } while (0)
#define PG8_WAIT_V(n) asm volatile("s_waitcnt vmcnt(" #n ")" ::: "memory")
#define PG8_WAIT_L(n) asm volatile("s_waitcnt lgkmcnt(" #n ")" ::: "memory")
#define PG8_BAR __builtin_amdgcn_s_barrier()
#define PG8_SCHED __builtin_amdgcn_sched_barrier(0)
    Unit cur, nxt; int ui = 0;
    if (!S.next(0, cur)) return;
    bool halfu = false, skip0 = false; if constexpr (Sched::HALFTAIL) { const int vr_ = __builtin_amdgcn_readfirstlane(cur.half); skip0 = 64 * wr >= vr_; halfu = 128 + 64 * wr >= vr_; }
    f32x4 acc[2][2][4][2];
#pragma unroll
    for (int a = 0; a < 2; ++a)
#pragma unroll
        for (int b = 0; b < 2; ++b)
#pragma unroll
            for (int m = 0; m < 4; ++m)
#pragma unroll
                for (int n = 0; n < 2; ++n) acc[a][b][m][n] = (f32x4){0.f, 0.f, 0.f, 0.f};
    bf16x8 At[4][2], B0[2][2], B1[2][2];
    const char* cA = cur.A; const char* cB = cur.B;
    if constexpr (GA) { PG8_TOKOFF(oA, cur); }
    {
        PG8_STAGE(PG8_SB(0, 0), cB, voffB); PG8_STAGE(PG8_SB(0, 1), cB + hstep, voffB); PG8_STAGE_A(PG8_SA(0, 0), cA, 0, oA); PG8_STAGE_A(PG8_SA(0, 1), cA, 1, oA);
        if (wr == 1) PG8_BAR;
        PG8_WAIT_V(2); PG8_BAR;
        PG8_STAGE(PG8_SB(1, 0), cB + kstep, voffB); PG8_STAGE_A(PG8_SA(1, 0), cA + kstep, 0, oA); PG8_STAGE(PG8_SB(1, 1), cB + hstep + kstep, voffB);
        PG8_WAIT_V(6); PG8_BAR;
    }
    for (;;) {
        const bool has_next = S.next(ui + 1, nxt);
        const char* nA = has_next ? nxt.A : cA; const char* nB = has_next ? nxt.B : cB;
        if constexpr (GA) { if (has_next) { PG8_TOKOFF(nO, nxt); } else {
#pragma unroll
            for (int _h = 0; _h < 2; ++_h) { nO[_h][0] = oA[_h][0]; nO[_h][1] = oA[_h][1]; } } }
        for (int t = 0; t < nt; t += 2) {
            const bool last = (t == nt - 2);
            const char* a1 = cA + (size_t)(t + 1) * kstep;
            const char* a2 = last ? nA : cA + (size_t)(t + 2) * kstep; const char* b2 = last ? nB : cB + (size_t)(t + 2) * kstep;
            const char* a3 = a2 + kstep; const char* b3 = b2 + kstep;
            unsigned sO[2][2];
#pragma unroll
            for (int _h = 0; _h < 2; ++_h) { sO[_h][0] = last ? nO[_h][0] : oA[_h][0]; sO[_h][1] = last ? nO[_h][1] : oA[_h][1]; }
            if (!skip0) { PG8_LDB(B0, 0, 0); PG8_LDB(B1, 0, 1); PG8_SCHED; PG8_LDA(At, 0, 0); }
            PG8_STAGE_A(PG8_SA(1, 1), a1, 1, oA);
            PG8_WAIT_V(8); PG8_WAIT_L(0); PG8_BAR; if (!skip0) { PG8_MMA(0, 0, At, B0); PG8_MMA(0, 1, At, B1); } PG8_BAR; PG8_SCHED;
            if (!halfu) PG8_LDA(At, 0, 1);
            PG8_STAGE(PG8_SB(0, 0), b2, voffB); PG8_STAGE(PG8_SB(0, 1), b2 + hstep, voffB); PG8_STAGE_A(PG8_SA(0, 0), a2, 0, sO);
            PG8_WAIT_V(8); PG8_WAIT_L(0); PG8_BAR; if (!halfu) { PG8_MMA(1, 0, At, B0); PG8_MMA(1, 1, At, B1); } PG8_BAR; PG8_SCHED;
            if (!skip0) { PG8_LDB(B0, 1, 0); PG8_LDB(B1, 1, 1); PG8_SCHED; PG8_LDA(At, 1, 0); }
            PG8_STAGE_A(PG8_SA(0, 1), a2, 1, sO);
            PG8_WAIT_V(8); PG8_WAIT_L(0); PG8_BAR; if (!skip0) { PG8_MMA(0, 0, At, B0); PG8_MMA(0, 1, At, B1); } PG8_BAR; PG8_SCHED;
            if (!halfu) PG8_LDA(At, 1, 1);
            PG8_STAGE(PG8_SB(1, 0), b3, voffB); PG8_STAGE(PG8_SB(1, 1), b3 + hstep, voffB); PG8_STAGE_A(PG8_SA(1, 0), a3, 0, sO);
            PG8_WAIT_V(8); PG8_WAIT_L(0); PG8_BAR; if (!halfu) { PG8_MMA(1, 0, At, B0); PG8_MMA(1, 1, At, B1); } PG8_BAR; PG8_SCHED;
        }
        if (wr == 0) PG8_BAR;
        E(acc, cur, wr, wc, fr, fq);
        if (!has_next) break;
#pragma unroll
        for (int a = 0; a < 2; ++a)
#pragma unroll
            for (int b = 0; b < 2; ++b)
#pragma unroll
                for (int m = 0; m < 4; ++m)
#pragma unroll
                    for (int n = 0; n < 2; ++n) acc[a][b][m][n] = (f32x4){0.f, 0.f, 0.f, 0.f};
        cur = nxt; cA = nA; cB = nB; ++ui;
        if constexpr (Sched::HALFTAIL) { const int vr_ = __builtin_amdgcn_readfirstlane(cur.half); skip0 = 64 * wr >= vr_; halfu = 128 + 64 * wr >= vr_; }
        if constexpr (GA) {
#pragma unroll
            for (int _h = 0; _h < 2; ++_h) { oA[_h][0] = nO[_h][0]; oA[_h][1] = nO[_h][1]; } }
        if (wr == 1) PG8_BAR;
    }
    PG8_WAIT_V(0);
    PG8_BAR;
#undef PG8_SA
#undef PG8_SB
#undef PG8_STAGE
#undef PG8_STAGE_A
#undef PG8_TOKOFF
#undef PG8_LDA
#undef PG8_LDB
#undef PG8_MMA
#undef PG8_WAIT_V
#undef PG8_WAIT_L
#undef PG8_BAR
#undef PG8_SCHED
}
}
using pg8::Unit;

DI void tr_item(const float* __restrict__ W, int N, int k0, int n0, bf16_t* __restrict__ WT, int ldt, int drow0, int dk0, LAS float* scr, int lane) {
    float tv[32];
    const float* wp = W + (size_t)(k0 + (lane >> 5)) * N + n0 + (lane & 31);
#pragma unroll
    for (int i = 0; i < 32; ++i) tv[i] = __builtin_nontemporal_load(wp + (size_t)(2 * i) * N);
#pragma unroll
    for (int i = 0; i < 32; ++i) scr[(2 * i + (lane >> 5)) * 33 + (lane & 31)] = tv[i];
    asm volatile("s_waitcnt lgkmcnt(0)" ::: "memory");
    const int c = lane & 7;
#pragma unroll
    for (int j = 0; j < 4; ++j) { const int n = (lane >> 3) + 8 * j; const LAS float* s = scr + (8 * c) * 33 + n;
        u32x4 o; o.x = cvt_pk_bf16(s[0 * 33], s[1 * 33]); o.y = cvt_pk_bf16(s[2 * 33], s[3 * 33]); o.z = cvt_pk_bf16(s[4 * 33], s[5 * 33]); o.w = cvt_pk_bf16(s[6 * 33], s[7 * 33]);
        *(u32x4*)(WT + (size_t)(drow0 + n) * ldt + dk0 + k0 + 8 * c) = o; }
    asm volatile("s_waitcnt lgkmcnt(0)" ::: "memory");
}
#define TRJOB(W_, K_, N_, WT_, LDT_, DROW_EXPR, DK0_) { const int _ni = ((K_) / 64) * ((N_) / 32); if (it < _ni) { const int _nb = (N_) / 32; const int _kb = it / _nb, _n0 = 32 * (it % _nb); const int n0 = _n0; (void)n0; \
        tr_item((W_), (N_), 64 * _kb, _n0, (WT_), (LDT_), (DROW_EXPR), (DK0_), scr, lane); return; } it -= _ni; }

DI void prologue_small_item(const Ctx& P, int it, LAS float* scr, int lane) {
    unsigned char* ws = P.ws;
    bf16_t* WAQKV = (bf16_t*)(ws + WS_WAQKV); bf16_t* WAO = (bf16_t*)(ws + WS_WAO); bf16_t* WCQKV = (bf16_t*)(ws + WS_WCQKV); bf16_t* WCO = (bf16_t*)(ws + WS_WCO);
    bf16_t* WBR = (bf16_t*)(ws + WS_WBRKVL); bf16_t* WBO = (bf16_t*)(ws + WS_WBO); bf16_t* WBL2 = (bf16_t*)(ws + WS_WBL2);
    TRJOB(P.in(I_AQKV), 1024, 1536, WAQKV, 1024, n0, 0)
    TRJOB(P.in(I_AQKV) + 1024 * 1536, 1024, 1536, WAQKV + 1536 * 1024, 1024, n0, 0)
    TRJOB(P.in(I_AO), 1024, 1024, WAO, 1024, n0, 0)
    TRJOB(P.in(I_AO) + 1024 * 1024, 1024, 1024, WAO + 1024 * 1024, 1024, n0, 0)
    TRJOB(P.in(I_CQKV), 1024, 1280, WCQKV, 1024, n0, 0)
    TRJOB(P.in(I_CO), 1024, 1024, WCO, 1024, n0, 0)
    TRJOB(P.in(I_BWR), 1024, 1024, WBR, 1024, n0, 0)
    TRJOB(P.in(I_BWK), 1024, 1024, WBR, 1024, 1024 + n0, 0)
    TRJOB(P.in(I_BWV), 1024, 1024, WBR, 1024, 2048 + n0, 0)
    TRJOB(P.in(I_BWO), 1024, 1024, WBO, 1024, n0, 0)
    TRJOB(P.in(I_BW1), 1024, 64, WBR, 1024, 3072 + n0, 0)
    TRJOB(P.in(I_BW1) + 65536, 1024, 64, WBR, 1024, 3072 + 64 + n0, 0)
    TRJOB(P.in(I_BA1), 1024, 64, WBR, 1024, 3328 + n0, 0)
    TRJOB(P.in(I_BA1) + 65536, 1024, 64, WBR, 1024, 3328 + 64 + n0, 0)
    TRJOB(P.in(I_BG1), 1024, 128, WBR, 1024, 3584 + n0, 0)
    TRJOB(P.in(I_BW2), 64, 1024, WBL2, 256, n0, 0)
    TRJOB(P.in(I_BW2) + 65536, 64, 1024, WBL2, 256, 1024 + n0, 64)
    TRJOB(P.in(I_BA2), 64, 1024, WBL2, 256, 2048 + n0, 128)
    TRJOB(P.in(I_BA2) + 65536, 64, 1024, WBL2, 256, 3072 + n0, 192)
    TRJOB(P.in(I_BG2), 128, 1024, WBL2, 256, 4096 + n0, 0)
}
constexpr int N_SMALL_ITEMS = 2 * 768 + 2 * 512 + 640 + 512 + 4 * 512 + 4 * 32 + 64 + 4 * 32 + 64;
constexpr int N_MOE_ITEMS_PER = 3 * 384, N_MOE_ITEMS = 128 * N_MOE_ITEMS_PER, N_MOE_PRO = 32 * N_MOE_ITEMS_PER;
static_assert(N_MOE_ITEMS - N_MOE_PRO == 108 * 1024, "scan-side conversion: 1024 staging waves x 108 chunks");
DI void prologue_moe_item(const Ctx& P, int item, LAS float* scr, int lane) {
    const int le = item / N_MOE_ITEMS_PER; int it = item % N_MOE_ITEMS_PER;
    bf16_t* W13 = (bf16_t*)(P.ws + WS_WM13) + (size_t)le * 1536 * 1024; bf16_t* W2 = (bf16_t*)(P.ws + WS_WM2) + (size_t)le * 1024 * 768;
    TRJOB(P.in(I_MW1) + (size_t)le * 1024 * 768, 1024, 768, W13, 1024, (n0 >> 7) * 256 + (n0 & 127), 0)
    TRJOB(P.in(I_MW3) + (size_t)le * 1024 * 768, 1024, 768, W13, 1024, (n0 >> 7) * 256 + 128 + (n0 & 127), 0)
    TRJOB(P.in(I_MW2) + (size_t)le * 768 * 1024, 768, 1024, W2, 768, n0, 0)
}

struct MoeItem { const float* src; bf16_t* dst; int N; };
DI MoeItem moe_item_decode(const float* w1, const float* w3, const float* w2, unsigned char* ws, int item, int lane, int& ldt) {
    const int le = item / N_MOE_ITEMS_PER, it = item % N_MOE_ITEMS_PER, job = it / 384, idx = it % 384;
    MoeItem m;
    if (job < 2) { const int kb = idx / 24, n0 = 32 * (idx % 24); m.N = 768; ldt = 1024;
        m.src = (job == 0 ? w1 : w3) + (size_t)le * 1024 * 768 + (size_t)(64 * kb + (lane >> 5)) * 768 + n0 + (lane & 31);
        m.dst = (bf16_t*)(ws + WS_WM13) + (size_t)le * 1536 * 1024 + (size_t)((n0 >> 7) * 256 + (job == 1 ? 128 : 0) + (n0 & 127)) * 1024 + 64 * kb;
    } else { const int kb = idx / 32, n0 = 32 * (idx % 32); m.N = 1024; ldt = 768;
        m.src = w2 + (size_t)le * 768 * 1024 + (size_t)(64 * kb + (lane >> 5)) * 1024 + n0 + (lane & 31);
        m.dst = (bf16_t*)(ws + WS_WM2) + (size_t)le * 1024 * 768 + (size_t)n0 * 768 + 64 * kb; }
    return m;
}
DI void moe_item_load(const MoeItem& m, float (&tv)[32]) {
    const int N2 = 2 * m.N; const __attribute__((address_space(1))) float* sp = (const __attribute__((address_space(1))) float*)m.src;
#pragma unroll
    for (int i = 0; i < 32; ++i) tv[i] = __builtin_nontemporal_load(sp + (size_t)i * N2);
}
DI void moe_item_store(const MoeItem& m, int ldt, const float (&tv)[32], LAS float* scr, int lane) {
#pragma unroll
    for (int i = 0; i < 32; ++i) scr[(2 * i + (lane >> 5)) * 33 + (lane & 31)] = tv[i];
    asm volatile("s_waitcnt lgkmcnt(0)" ::: "memory");
    const int c = lane & 7;
#pragma unroll
    for (int j = 0; j < 4; ++j) { const int n = (lane >> 3) + 8 * j; const LAS float* sp = scr + (8 * c) * 33 + n;
        u32x4 o; o.x = cvt_pk_bf16(sp[0 * 33], sp[1 * 33]); o.y = cvt_pk_bf16(sp[2 * 33], sp[3 * 33]); o.z = cvt_pk_bf16(sp[4 * 33], sp[5 * 33]); o.w = cvt_pk_bf16(sp[6 * 33], sp[7 * 33]);
        *(u32x4*)(m.dst + (size_t)n * ldt + 8 * c) = o; }
    asm volatile("s_waitcnt lgkmcnt(0)" ::: "memory");
}
DI void phase_prologue(const Ctx& P, LAS unsigned char* lds, int tid, int lane, int wave) {
    const int G = gridDim.x, bx = blockIdx.x;
    unsigned char* ws = P.ws;
    LAS float* cond = (LAS float*)lds;
    LAS float* part = (LAS float*)(lds + 12288);
    { const float* cp = P.in(I_C); const float* ccp = P.in(I_CCTX);
#pragma unroll
      for (int q = 0; q < 6; ++q) { const int i = tid + 512 * q, v = i >> 10, k = i & 1023; const float c = (v < 2) ? cp[v * 1024 + k] : ccp[k]; cond[i] = silu_f(c); } }
    __syncthreads();
    float* MOD = (float*)(ws + WS_MOD);
    const float* modw = P.in(I_MODW); const float* modb = P.in(I_MODB);
    for (int u = bx; u < 4 * 96; u += G) {
        const int l = u / 96, c0 = (u % 96) * 64;
        const float* W = modw + (size_t)l * 1024 * 6144 + c0 + lane;
        float a0 = 0.f, a1 = 0.f, a2 = 0.f;
        const int kb = wave * 128;
#pragma unroll 16
        for (int k = 0; k < 128; ++k) { const float w = W[(size_t)(kb + k) * 6144]; a0 += cond[kb + k] * w; a1 += cond[1024 + kb + k] * w; a2 += cond[2048 + kb + k] * w; }
        part[(wave * 3 + 0) * 64 + lane] = a0; part[(wave * 3 + 1) * 64 + lane] = a1; part[(wave * 3 + 2) * 64 + lane] = a2;
        __syncthreads();
        if (tid < 192) { const int v = tid >> 6, c = tid & 63; float s = 0.f;
#pragma unroll
            for (int w = 0; w < 8; ++w) s += part[(w * 3 + v) * 64 + c];
            const int j = c0 + c; MOD[((size_t)(l * 3 + v) * 6 + (j >> 10)) * 1024 + (j & 1023)] = s + modb[l * 6144 + j]; }
        __syncthreads();
    }
    const int gt = bx * 512 + tid, NGT = G * 512;
    {
        float* RT = (float*)(ws + WS_ROPE);
        for (int i = gt; i < 128 * 16; i += NGT) { const int p = i >> 4, f = i & 15; const float inv = powf(10000.0f, -(float)(2 * f) / 32.0f); const float ang = (float)p * inv; RT[2 * i] = cosf(ang); RT[2 * i + 1] = sinf(ang); }
        float* WR = (float*)(ws + WS_WR); const float* mwg = P.in(I_MWG); const float* mwe = P.in(I_MWE);
        for (int i = gt; i < 4 * 36 * 1024; i += NGT) { const int l = i / (36 * 1024), r = i % (36 * 1024), j = r >> 10, k = r & 1023;
            WR[i] = (j < 4) ? mwg[((size_t)l * 1024 + k) * 4 + j] : mwe[((size_t)l * 1024 + k) * 32 + (j - 4)]; }
        bf16_t* WBR = (bf16_t*)(ws + WS_WBRKVL);
        for (int i = gt; i < 3 * 128 * 128; i += NGT) { const int seg = i / (128 * 128), r = (i / 128) % 128, ch = i % 128; *(u32x4*)(WBR + (size_t)(3072 + seg * 256 + 128 + r) * 1024 + ch * 8) = (u32x4){0u, 0u, 0u, 0u}; }
        bf16_t* WBL2 = (bf16_t*)(ws + WS_WBL2);
        for (int i = gt; i < 5120 * 32; i += NGT) { const int r = i >> 5, ch = i & 31, k = ch * 8; int lo, hi;
            if (r < 2048) { lo = 64 * (r >> 10); hi = lo + 64; } else if (r < 4096) { lo = 128 + 64 * ((r - 2048) >> 10); hi = lo + 64; } else { lo = 0; hi = 128; }
            if (k < lo || k >= hi) *(u32x4*)(WBL2 + (size_t)r * 256 + k) = (u32x4){0u, 0u, 0u, 0u}; }
    }
    LAS float* scr = (LAS float*)(lds + 20480 + wave * 8704);
    const int gw = bx * 8 + wave, NGW = G * 8;
    for (int it = gw; it < N_SMALL_ITEMS; it += NGW) prologue_small_item(P, it, scr, lane);
    const int n_moe_here = (G == 256) ? N_MOE_PRO : N_MOE_ITEMS;
    {   const float* mw1 = P.in(I_MW1); const float* mw3 = P.in(I_MW3); const float* mw2 = P.in(I_MW2);
        MoeItem ma, mb; float ta[32], tb[32]; int lda = 0, ldb = 0;
        int it = gw;
        if (it < n_moe_here) { ma = moe_item_decode(mw1, mw3, mw2, ws, it, lane, lda); moe_item_load(ma, ta); }
        for (; it < n_moe_here; it += 2 * NGW) {
            const int itb = it + NGW, itc = it + 2 * NGW; const bool hb = itb < n_moe_here;
            if (hb) { mb = moe_item_decode(mw1, mw3, mw2, ws, itb, lane, ldb); moe_item_load(mb, tb); }
            moe_item_store(ma, lda, ta, scr, lane);
            if (itc < n_moe_here) { ma = moe_item_decode(mw1, mw3, mw2, ws, itc, lane, lda); moe_item_load(ma, ta); }
            if (hb) moe_item_store(mb, ldb, tb, scr, lane);
        }
    }
}

DI void row_load(const float* p, int lane, f32x4 (&v)[4]) {
#pragma unroll
    for (int j = 0; j < 4; ++j) v[j] = ((const f32x4*)p)[lane + 64 * j];
}
DI void row_load_x(const bf16_t* p, int lane, f32x4 (&v)[4]) {
#pragma unroll
    for (int j = 0; j < 4; ++j) { const u32x2 w = ((const u32x2*)p)[lane + 64 * j]; v[j] = (f32x4){__uint_as_float(w[0] << 16), __uint_as_float(w[0] & 0xffff0000u), __uint_as_float(w[1] << 16), __uint_as_float(w[1] & 0xffff0000u)}; }
}
DI void row_store(float* p, int lane, const f32x4 (&v)[4]) {
#pragma unroll
    for (int j = 0; j < 4; ++j) ((f32x4*)p)[lane + 64 * j] = v[j];
}
DI void row_store_bf16(bf16_t* p, int lane, const f32x4 (&v)[4]) {
#pragma unroll
    for (int j = 0; j < 4; ++j) ((u32x2*)p)[lane + 64 * j] = (u32x2){cvt_pk_bf16(v[j][0], v[j][1]), cvt_pk_bf16(v[j][2], v[j][3])};
}
DI float row_sumsq(const f32x4 (&v)[4]) {
    float s = 0.f;
#pragma unroll
    for (int j = 0; j < 4; ++j) s += (v[j][0] * v[j][0] + v[j][1] * v[j][1]) + (v[j][2] * v[j][2] + v[j][3] * v[j][3]);
    return wave_sum(s);
}
DI int moe_tables(const Ctx& P, int l, LAS unsigned char* lds, int tid);
DI void moe_combine(const Ctx& P, int lprev, int row, int lane, f32x4 (&x)[4], const LAS int* start) {
    const unsigned char* ws = P.ws;
    const int2 e_ = ((const int2*)(ws + WS_TOK))[row], p_ = ((const int2*)(ws + WS_TOK + TOK_STRIDE))[row];
    const int2 d = make_int2(start[e_.x] + p_.x, start[e_.y] + p_.y);
    const float2 w = ((const float2*)(ws + WS_TOK + 2 * TOK_STRIDE))[row];
    const bf16_t* Y = (const bf16_t*)(ws + WS_YASG);
    const float* gate = (const float*)(ws + WS_MOD) + ((size_t)(lprev * 3 + vec_of_row(row)) * 6 + 5) * 1024;
#pragma unroll
    for (int j = 0; j < 4; ++j) {
        const u32x2 y0 = ((const u32x2*)(Y + (size_t)d.x * 1024))[lane + 64 * j], y1 = ((const u32x2*)(Y + (size_t)d.y * 1024))[lane + 64 * j];
        const f32x4 g = ((const f32x4*)gate)[lane + 64 * j];
        x[j][0] += g[0] * (w.x * bf_lo(y0.x) + w.y * bf_lo(y1.x)); x[j][1] += g[1] * (w.x * bf_hi(y0.x) + w.y * bf_hi(y1.x));
        x[j][2] += g[2] * (w.x * bf_lo(y0.y) + w.y * bf_lo(y1.y)); x[j][3] += g[3] * (w.x * bf_hi(y0.y) + w.y * bf_hi(y1.y));
    }
}
DI void modulate_row(const f32x4 (&x)[4], f32x4 (&h)[4], const float* g, const float* shift, const float* scale, int lane) {
    const float rstd = rsqrtf(row_sumsq(x) * (1.0f / DM) + NORM_EPS);
#pragma unroll
    for (int j = 0; j < 4; ++j) { const f32x4 gg = ((const f32x4*)g)[lane + 64 * j], sc = ((const f32x4*)scale)[lane + 64 * j], sh = ((const f32x4*)shift)[lane + 64 * j];
        h[j] = (x[j] * rstd) * gg * (sc + 1.0f) + sh; }
}

DI void phase_norm1(const Ctx& P, int l, bool rwkv, LAS unsigned char* lds, int tid, int lane, int gw, int NGW) {
    unsigned char* ws = P.ws;
    const LAS int* start = (const LAS int*)(lds + LDS_MISC + MISC_START);
    bf16_t* XOUT = (bf16_t*)(ws + xres_of(l)); const bf16_t* XIN = (const bf16_t*)(ws + (l > 0 ? xres_of(l - 1) : WS_XRES)); const float* MOD = (const float*)(ws + WS_MOD);
    const float* xin = P.in(I_X); const float* cin = P.in(I_CTX); const float* n1g = P.in(I_N1G) + l * DM;
    if (!rwkv) {
        for (int row = gw; row < MROWS; row += 2 * NGW) {
            const bool two = row + NGW < MROWS; const int rowb = two ? row + NGW : row;
            f32x4 xa[4], xb[4], h[4];
            if (l == 0) { row_load(row < NCTXR ? cin + (size_t)row * DM : xin + (size_t)(row - NCTXR) * DM, lane, xa); row_load(rowb < NCTXR ? cin + (size_t)rowb * DM : xin + (size_t)(rowb - NCTXR) * DM, lane, xb); }
            else { row_load_x(XIN + (size_t)row * DM, lane, xa); row_load_x(XIN + (size_t)rowb * DM, lane, xb); moe_combine(P, l - 1, row, lane, xa, start); moe_combine(P, l - 1, rowb, lane, xb, start); }
            row_store_bf16(XOUT + (size_t)row * DM, lane, xa);
            { const float* m = MOD + (size_t)(l * 3 + vec_of_row(row)) * 6 * 1024; modulate_row(xa, h, n1g, m, m + 1024, lane); row_store_bf16((bf16_t*)(ws + WS_HA0) + (size_t)row * DM, lane, h); }
            if (two) { row_store_bf16(XOUT + (size_t)rowb * DM, lane, xb);
                const float* m = MOD + (size_t)(l * 3 + vec_of_row(rowb)) * 6 * 1024; modulate_row(xb, h, n1g, m, m + 1024, lane); row_store_bf16((bf16_t*)(ws + WS_HA0) + (size_t)rowb * DM, lane, h); }
        }
        return;
    }
    bf16_t* MIX = (bf16_t*)(ws + WS_MIX); const float* mu = P.in(I_BMU);
    const int wv = gw & 7, blk = gw >> 3;
    for (int b66 = blk; b66 * 66 < MROWS; b66 += NGW >> 3) {
        const int r0 = b66 * 66 + (wv < 2 ? 9 * wv : 18 + 8 * (wv - 2)), r1 = r0 + (wv < 2 ? 9 : 8);
        f32x4 hm[4], hc[4], hn[4];
#pragma unroll
        for (int j = 0; j < 4; ++j) { hm[j] = (f32x4){0.f, 0.f, 0.f, 0.f}; hc[j] = hm[j]; hn[j] = hm[j]; }
        for (int i = r0 - 1; i <= r1; ++i) {
#pragma unroll
            for (int j = 0; j < 4; ++j) { hm[j] = hc[j]; hc[j] = hn[j]; }
            if (i >= 0 && i < MROWS) { f32x4 x[4];
                row_load_x(XIN + (size_t)i * DM, lane, x); moe_combine(P, l - 1, i, lane, x, start);
                if (i >= r0 && i < r1) row_store_bf16(XOUT + (size_t)i * DM, lane, x);
                const float* m = MOD + (size_t)(l * 3 + vec_of_row(i)) * 6 * 1024;
                modulate_row(x, hn, n1g, m, m + 1024, lane);
            } else {
#pragma unroll
                for (int j = 0; j < 4; ++j) hn[j] = (f32x4){0.f, 0.f, 0.f, 0.f}; }
            const int t = i - 1;
            if (t >= r0 && t < r1) {
                int tt, T; if (t < NCTXR) { tt = t & 255; T = NCTX; } else { tt = (t - NCTXR) & 8191; T = SEQ; }
                const float wp = tt > 0 ? 0.5f : 0.0f, wn = tt < T - 1 ? 0.5f : 0.0f;
                f32x4 xx[4];
#pragma unroll
                for (int j = 0; j < 4; ++j) xx[j] = hm[j] * wp + hn[j] * wn - hc[j];
#pragma unroll
                for (int q = 0; q < 6; ++q) { f32x4 o[4];
#pragma unroll
                    for (int j = 0; j < 4; ++j) o[j] = hc[j] + xx[j] * ((const f32x4*)(mu + q * DM))[lane + 64 * j];
                    row_store_bf16(MIX + (size_t)q * ROWB + (size_t)t * DM, lane, o); }
            }
        }
    }
}
DI void phase_final(const Ctx& P, LAS unsigned char* lds, int tid, int lane, int gw, int NGW) {
    const LAS int* start = (const LAS int*)(lds + LDS_MISC + MISC_START);
    const bf16_t* XRES = (const bf16_t*)(P.ws + xres_of(DEPTH - 1)); const float* fg = P.in(I_FG); float* outp = P.out;
    for (int row = NCTXR + gw; row < MROWS; row += NGW) {
        f32x4 x[4]; row_load_x(XRES + (size_t)row * DM, lane, x); moe_combine(P, DEPTH - 1, row, lane, x, start);
        const float rstd = rsqrtf(row_sumsq(x) * (1.0f / DM) + NORM_EPS);
#pragma unroll
        for (int j = 0; j < 4; ++j) { const f32x4 gg = ((const f32x4*)fg)[lane + 64 * j]; ((f32x4*)(outp + (size_t)(row - NCTXR) * DM))[lane + 64 * j] = (x[j] * rstd) * gg; }
    }
}
DI void phase_norm2_router(const Ctx& P, int l, LAS unsigned char* lds, int tid, int lane, int gw, int NGW, bool dry = false) {
    unsigned char* ws = P.ws;
    const bf16_t* XRES = (const bf16_t*)(ws + xres_of(l)); const float* MOD = (const float*)(ws + WS_MOD);
    bf16_t* HA0 = (bf16_t*)(ws + WS_HA0);
    LAS f32x4* WRl = (LAS f32x4*)lds;
    { const f32x4* src = (const f32x4*)((const float*)(ws + WS_WR) + (size_t)l * 36 * 1024);
      f32x4 wr_[18];
#pragma unroll
      for (int q = 0; q < 18; ++q) wr_[q] = src[tid + 512 * q];
#pragma unroll
      for (int q = 0; q < 18; ++q) WRl[tid + 512 * q] = wr_[q]; }
    LAS int* lc = (LAS int*)(lds + LDS_MISC + 1792); LAS int* lbase = lc + 32; LAS int* rec = (LAS int*)(lds + LDS_MISC + 2048);
    if (tid < 32) lc[tid] = 0;
    __syncthreads();
    unsigned* CNT = (unsigned*)(ws + WS_CTL) + CW_CNT + l * 32 * CNT_STRIDE;
    int* LIST = (int*)(ws + WS_LIST);
    int2* TOK_E = (int2*)(ws + WS_TOK); int2* TOK_POS = (int2*)(ws + WS_TOK + TOK_STRIDE); float2* TOK_W = (float2*)(ws + WS_TOK + 2 * TOK_STRIDE);
    const int row0 = (l == DEPTH - 1) ? NCTXR : 0;
    const float* n2g = P.in(I_N2G) + l * DM; const float* mbg = P.in(I_MBG) + l * 4; const float* mbe = P.in(I_MBE) + l * 32;
    int kk_ = 0;
    for (int row = row0 + gw; row < MROWS; row += NGW, ++kk_) {
        f32x4 x[4], h[4];
        row_load_x(XRES + (size_t)row * DM, lane, x);
        if (row < NCTXR) {
            const float* part = (const float*)(ws + WS_PART) + (size_t)row * DM; const float* g1 = MOD + ((size_t)(l * 3 + 2) * 6 + 2) * 1024;
#pragma unroll
            for (int j = 0; j < 4; ++j) { f32x4 a = ((const f32x4*)part)[lane + 64 * j];
#pragma unroll
                for (int ks = 1; ks < 8; ++ks) a = a + ((const f32x4*)(part + (size_t)ks * NCTXR * DM))[lane + 64 * j];
                x[j] = x[j] + ((const f32x4*)g1)[lane + 64 * j] * a; }
            row_store_bf16((bf16_t*)(ws + xres_of(l)) + (size_t)row * DM, lane, x);
        }
        const float* m = MOD + ((size_t)(l * 3 + vec_of_row(row)) * 6 + 3) * 1024;
        modulate_row(x, h, n2g, m, m + 1024, lane);
        row_store_bf16(HA0 + (size_t)row * DM, lane, h);
        auto logit4 = [&](int g) { float pt[4];
#pragma unroll
            for (int q = 0; q < 4; ++q) { const int e = 4 * g + q; f32x4 a = h[0] * WRl[e * 256 + lane];
#pragma unroll
                for (int j = 1; j < 4; ++j) a = h[j] * WRl[e * 256 + lane + 64 * j] + a;
                pt[q] = (a[0] + a[1]) + (a[2] + a[3]); }
            float t4 = merge4_reduce16(pt[0], pt[1], pt[2], pt[3], lane);
            t4 += __shfl_xor(t4, 16); t4 += __shfl_xor(t4, 32);
            __builtin_amdgcn_sched_barrier(0); return t4; };
        const float grp0 = logit4(0);
        float lg[4];
#pragma unroll
        for (int e = 0; e < 4; ++e) lg[e] = __builtin_bit_cast(float, __builtin_amdgcn_readlane(__builtin_bit_cast(int, grp0), e)) + mbg[e];
        int gi = 0; float gm = lg[0];
#pragma unroll
        for (int e = 1; e < 4; ++e) if (lg[e] > gm) { gm = lg[e]; gi = e; }
        gi = __builtin_amdgcn_readfirstlane(gi);
        float gs = 0.f;
#pragma unroll
        for (int e = 0; e < 4; ++e) gs += __expf(lg[e] - gm);
        const float gwt = 1.0f / gs;
        const float elA = logit4(1 + 2 * gi);
        const float elB = logit4(2 + 2 * gi);
        float el[8];
#pragma unroll
        for (int k = 0; k < 4; ++k) { el[k] = __builtin_bit_cast(float, __builtin_amdgcn_readlane(__builtin_bit_cast(int, elA), k)) + mbe[8 * gi + k];
                                      el[4 + k] = __builtin_bit_cast(float, __builtin_amdgcn_readlane(__builtin_bit_cast(int, elB), k)) + mbe[8 * gi + 4 + k]; }
        int i1 = 0; float m1 = el[0];
#pragma unroll
        for (int k = 1; k < 8; ++k) if (el[k] > m1) { m1 = el[k]; i1 = k; }
        int i2 = -1; float m2 = -3.0e38f;
#pragma unroll
        for (int k = 0; k < 8; ++k) if (k != i1 && el[k] > m2) { m2 = el[k]; i2 = k; }
        const float r = __expf(m2 - m1);
        const float w1 = gwt / (1.0f + r), w2 = gwt * r / (1.0f + r);
        if (lane == 0 && !dry) {
            const int e1 = gi * 8 + i1, e2 = gi * 8 + i2;
            const int lp1 = __hip_atomic_fetch_add(&lc[e1], 1, __ATOMIC_RELAXED, __HIP_MEMORY_SCOPE_WORKGROUP), lp2 = __hip_atomic_fetch_add(&lc[e2], 1, __ATOMIC_RELAXED, __HIP_MEMORY_SCOPE_WORKGROUP);
            LAS int* r = rec + ((gw & 7) * 9 + kk_) * 6; r[0] = e1; r[1] = e2; r[2] = lp1; r[3] = lp2; r[4] = __float_as_int(w1); r[5] = __float_as_int(w2);
        }
    }
    if (!dry) {
        __syncthreads();
        if (tid < 32) { const int n = lc[tid]; lbase[tid] = n ? (int)atomicAdd(&CNT[tid * CNT_STRIDE], (unsigned)n) : 0; }
        __syncthreads();
        if (tid < 72) { const int w_ = tid / 9, k_ = tid - 9 * w_, row = row0 + (gw >> 3) * 8 + w_ + k_ * NGW;
            if (row < MROWS) { const LAS int* r = rec + tid * 6; const int e1 = r[0], e2 = r[1], p1 = lbase[e1] + r[2], p2 = lbase[e2] + r[3];
                TOK_E[row] = make_int2(e1, e2); TOK_POS[row] = make_int2(p1, p2); TOK_W[row] = make_float2(__int_as_float(r[4]), __int_as_float(r[5]));
                LIST[(size_t)e1 * MROWS + p1] = row; LIST[(size_t)e2 * MROWS + p2] = row; } }
    }
}
DI int moe_tables(const Ctx& P, int l, LAS unsigned char* lds, int tid) {
    LAS int* start = (LAS int*)(lds + LDS_MISC + MISC_START); LAS int* blk_e = (LAS int*)(lds + LDS_MISC + MISC_BLKE);
    const unsigned* CNT = (const unsigned*)(P.ws + WS_CTL) + CW_CNT + l * 32 * CNT_STRIDE;
    LAS int* cnt_l = (LAS int*)(lds + LDS_MISC + MISC_CNTL);
    __syncthreads();
    if (tid < NEXP) cnt_l[tid] = (int)__hip_atomic_load(CNT + tid * CNT_STRIDE, __ATOMIC_RELAXED, __HIP_MEMORY_SCOPE_AGENT);
    __syncthreads();
    if (tid < 64) {
        const int nb = tid < NEXP ? (cnt_l[tid & (NEXP - 1)] + 255) >> 8 : 0; int inc = nb;
#pragma unroll
        for (int o = 1; o < 32; o <<= 1) { const int v = __shfl_up(inc, o); if ((tid & 63) >= o) inc += v; }
        const int ex = inc - nb;
        if (tid < NEXP) { start[tid] = ex << 8; for (int b = 0; b < nb; ++b) blk_e[ex + b] = tid; if (tid == NEXP - 1) start[NEXP] = inc << 8; }
    }
    __syncthreads();
    return start[NEXP] >> 8;
}
template <int WGM = 8> DI bool unit_order(int i, int G, int c, int nM, int nN, int& pm, int& pn) {
    const int nwg = nM * nN, L = i * G + c; if (L >= nwg) return false;
    int w; { const int q = nwg / 8, r = nwg % 8, xcd = L % 8, off = L / 8; w = (xcd < r ? xcd * (q + 1) : r * (q + 1) + (xcd - r) * q) + off; }
    const int nig = WGM * nN, gid = w / nig, fm = gid * WGM, gsz = (nM - fm) < WGM ? (nM - fm) : WGM;
    pm = fm + ((w % nig) % gsz); pn = (w % nig) / gsz; return true;
}
struct SchedDense {
    static constexpr bool GATHER = false; static constexpr bool HALFTAIL = false;
    const char* A; const char* B; int nM, nN, G, c, pm0; size_t tileb;
    DI bool next(int i, Unit& u) const { int pm, pn; if (!unit_order(i, G, c, nM, nN, pm, pn)) return false; u.pm = pm0 + pm; u.pn = pn; u.A = A + (size_t)u.pm * tileb; u.B = B + (size_t)u.pn * tileb; return true; }
};
struct SchedCtxSplit {
    static constexpr bool GATHER = false; static constexpr bool HALFTAIL = false;
    static constexpr bool HOOKS = false;
    const char* A; const char* B; int c;
    DI bool next(int i, Unit& u) const { if (i > 0 || c >= 64) return false; const int ks = c & 7, pn = (c >> 3) & 3; u.pm = c >> 5; u.pn = pn | (ks << 2);
        u.A = A + (size_t)u.pm * (256 * 1024 * 2) + ks * 256; u.B = B + (size_t)pn * (256 * 1024 * 2) + ks * 256; return true; }
};
struct SchedRkvl {
    static constexpr bool GATHER = false; static constexpr bool HALFTAIL = false;
    const char* MIX; const char* B; int G, c;
    DI bool next(int i, Unit& u) const { if (!unit_order(i, G, c, 66, 15, u.pm, u.pn)) return false;
        const int slot = u.pn < 4 ? 0 : u.pn < 8 ? 2 : u.pn < 12 ? 3 : u.pn == 12 ? 1 : u.pn == 13 ? 4 : 5;
        u.A = MIX + (size_t)slot * ROWB * 2 + (size_t)u.pm * 256 * 1024 * 2; u.B = B + (size_t)u.pn * 256 * 1024 * 2; return true; }
};
struct SchedLora2 {
    static constexpr bool GATHER = false; static constexpr bool HALFTAIL = false;
    const char* TWA; const char* TG; const char* B; int G, c;
    DI bool next(int i, Unit& u) const { if (!unit_order(i, G, c, 66, 20, u.pm, u.pn)) return false;
        const int ko = (u.pn >= 8 && u.pn < 16) ? 256 : 0;
        u.A = (u.pn < 16 ? TWA : TG) + (size_t)u.pm * 256 * 256 * 2 + ko; u.B = B + (size_t)u.pn * 256 * 256 * 2 + ko; return true; }
};
struct SchedMoe {
    static constexpr bool GATHER = false; static constexpr bool HALFTAIL = true;
    const char* A; const char* B; int nM, nN, G, c; size_t atile, btile, bexp; const LAS int* blk_e; const LAS int* start; const LAS int* cnt;
    DI bool next(int i, Unit& u) const { if (!unit_order<2>(i, G, c, nM, nN, u.pm, u.pn)) return false;
        const int e = blk_e[u.pm]; u.half = cnt[e] - (u.pm * 256 - start[e]);
        u.A = A + (size_t)u.pm * atile; u.B = B + (size_t)e * bexp + (size_t)u.pn * btile; return true; }
};

struct SchedMoeG {
    static constexpr bool GATHER = true; static constexpr bool HALFTAIL = true;
    const char* A; const char* B; int nM, G, c; const LAS int* blk_e; const LAS int* ltok; const LAS int* start; const LAS int* cnt;
    DI bool next(int i, Unit& u) const { if (!unit_order<2>(i, G, c, nM, 6, u.pm, u.pn)) return false;
        const int e = blk_e[u.pm]; u.half = cnt[e] - (u.pm * 256 - start[e]);
        u.A = A; u.B = B + (size_t)e * ((size_t)1536 * 1024 * 2) + (size_t)u.pn * (256 * 1024 * 2); u.tok = i * 256; return true; }
    DI int tokrow(int idx) const { return ltok[idx]; }
};
constexpr int LDS_LTOK = 131072;
#define EPI_LOOP_BEGIN _Pragma("unroll") for (int ai = 0; ai < 2; ++ai) _Pragma("unroll") for (int m = 0; m < 4; ++m) { const int row = u.pm * 256 + ai * 128 + wr * 64 + m * 16 + fr;
#define EPI_LOOP_END }
DI u32x4 pack8_bf16(const f32x4& a, const f32x4& b) { return (u32x4){cvt_pk_bf16(a[0], a[1]), cvt_pk_bf16(a[2], a[3]), cvt_pk_bf16(b[0], b[1]), cvt_pk_bf16(b[2], b[3])}; }
DI h16x8 pack8_h16(const f32x4& a, const f32x4& b) { return (h16x8){(h16)a[0], (h16)a[1], (h16)a[2], (h16)a[3], (h16)b[0], (h16)b[1], (h16)b[2], (h16)b[3]}; }

DI f32x4 sigmoid4(f32x4 x) { f32x4 r; r[0] = sigmoid_f(x[0]); r[1] = sigmoid_f(x[1]); r[2] = sigmoid_f(x[2]); r[3] = sigmoid_f(x[3]); return r; }
DI float decay_e(float wl) { const float lw = -0.6065306597126334f * __builtin_amdgcn_rcpf(1.0f + __expf(-wl)); return 1.0f - __expf(lw); }
DI f32x4 decay_e4(f32x4 x) { f32x4 r; r[0] = decay_e(x[0]); r[1] = decay_e(x[1]); r[2] = decay_e(x[2]); r[3] = decay_e(x[3]); return r; }
DI float tanh_f(float x) { return 1.0f - 2.0f * __builtin_amdgcn_rcpf(__expf(2.0f * x) + 1.0f); }
struct EpiQKV {
    static constexpr bool PERM = true;
    bf16_t* Q; bf16_t* K; bf16_t* V; int dense; const float* qgain; const float* kgain; const float* RT; LAS float* xch;
    DI void operator()(const f32x4 (&acc)[2][2][4][2], const Unit& u, int wr, int wc, int fr, int fq) const {
        if (dense && u.pn == 5) {
            EPI_LOOP_BEGIN
                bf16_t* dst = V + (size_t)kvrow_of(row) * 256 + wc * 32 + 8 * fq;
#pragma unroll
                for (int bj = 0; bj < 2; ++bj) *(u32x4*)(dst + bj * 128) = pack8_bf16(acc[ai][bj][m][0], acc[ai][bj][m][1]);
            EPI_LOOP_END
            return;
        }
        const bool isQ = u.pn < 4; const int wid = wr * 4 + wc; const bool lat = u.pm >= 2; const int axis = wc & 1;
        if (dense) {
#pragma unroll
            for (int ai = 0; ai < 2; ++ai)
#pragma unroll
                for (int bj = 0; bj < 2; ++bj)
#pragma unroll
                    for (int m = 0; m < 4; ++m) { const f32x4 a = acc[ai][bj][m][0], b = acc[ai][bj][m][1];
                        float ss = (a[0] * a[0] + a[1] * a[1]) + (a[2] * a[2] + a[3] * a[3]) + (b[0] * b[0] + b[1] * b[1]) + (b[2] * b[2] + b[3] * b[3]);
                        ss += __shfl_xor(ss, 16); ss += __shfl_xor(ss, 32);
                        if (fq == 0) xch[wid * 256 + ((ai * 2 + bj) * 4 + m) * 16 + fr] = ss; }
            asm volatile("s_waitcnt lgkmcnt(0)" ::: "memory"); __builtin_amdgcn_s_barrier(); asm volatile("" ::: "memory");
        }
        const int d0 = (32 * wc + 8 * fq) & 63;
        const float scale = isQ ? C2 : 1.0f;
        f32x4 g0 = (f32x4){scale, scale, scale, scale}, g1 = g0;
        if (dense) { const float* gp = (isQ ? qgain : kgain) + d0; g0 = *(const f32x4*)gp * scale; g1 = *(const f32x4*)(gp + 4) * scale; }
        EPI_LOOP_BEGIN
            const size_t kr = (size_t)kvrow_of(row);
            const int t = (row - NCTXR) & 8191, pos = axis ? (t & 63) : (t >> 6);
            const float* rt = RT + pos * 32 + ((8 * fq) & 15) * 2;
            f32x4 c0 = (f32x4){1.f, 0.f, 1.f, 0.f}, c1 = c0, c2 = c0, c3 = c0;
            if (lat) { c0 = *(const f32x4*)rt; c1 = *(const f32x4*)(rt + 4); c2 = *(const f32x4*)(rt + 8); c3 = *(const f32x4*)(rt + 12); }
#pragma unroll
            for (int bj = 0; bj < 2; ++bj) {
                if (!dense && !isQ && bj == 1) { *(u32x4*)(V + kr * 128 + wc * 32 + 8 * fq) = pack8_bf16(acc[ai][1][m][0], acc[ai][1][m][1]); continue; }
                f32x4 a = acc[ai][bj][m][0] * g0, b = acc[ai][bj][m][1] * g1;
                if (dense) { const int xi = ((ai * 2 + bj) * 4 + m) * 16 + fr; const float rs = rsqrtf((xch[wid * 256 + xi] + xch[(wid ^ 1) * 256 + xi]) * (1.0f / 64.0f) + NORM_EPS); a = a * rs; b = b * rs; }
                if (lat) {
                    f32x4 pa, pb;
#pragma unroll
                    for (int q = 0; q < 4; ++q) { pa[q] = __shfl_xor(a[q], 32); pb[q] = __shfl_xor(b[q], 32); }
                    const float sg = fq < 2 ? -1.0f : 1.0f;
                    a[0] = a[0] * c0[0] + sg * pa[0] * c0[1]; a[1] = a[1] * c0[2] + sg * pa[1] * c0[3]; a[2] = a[2] * c1[0] + sg * pa[2] * c1[1]; a[3] = a[3] * c1[2] + sg * pa[3] * c1[3];
                    b[0] = b[0] * c2[0] + sg * pb[0] * c2[1]; b[1] = b[1] * c2[2] + sg * pb[1] * c2[3]; b[2] = b[2] * c3[0] + sg * pb[2] * c3[1]; b[3] = b[3] * c3[2] + sg * pb[3] * c3[3];
                }
                bf16_t* dst = isQ ? Q + (size_t)row * DM + u.pn * 256 : K + kr * (dense ? 256 : 128);
                *(u32x4*)(dst + bj * 128 + wc * 32 + 8 * fq) = pack8_bf16(a, b);
            }
        EPI_LOOP_END
    }
};
struct EpiResid {
    static constexpr bool PERM = true;
    bf16_t* X; const float* gate_l; float scale;
    DI void operator()(const f32x4 (&acc)[2][2][4][2], const Unit& u, int wr, int wc, int fr, int fq) const {
        const int v = u.pm < 2 ? 2 : ((u.pm - 2) >> 5);
        const float* g = gate_l + (size_t)v * 6 * 1024;
        EPI_LOOP_BEGIN
#pragma unroll
            for (int bj = 0; bj < 2; ++bj) { const int col = u.pn * 256 + bj * 128 + wc * 32 + 8 * fq; u32x4* p = (u32x4*)(X + (size_t)row * DM + col); const u32x4 w = *p;
                const f32x4 g0 = *(const f32x4*)(g + col), g1 = *(const f32x4*)(g + col + 4);
                const f32x4 x0 = (f32x4){__uint_as_float(w[0] << 16), __uint_as_float(w[0] & 0xffff0000u), __uint_as_float(w[1] << 16), __uint_as_float(w[1] & 0xffff0000u)};
                const f32x4 x1 = (f32x4){__uint_as_float(w[2] << 16), __uint_as_float(w[2] & 0xffff0000u), __uint_as_float(w[3] << 16), __uint_as_float(w[3] & 0xffff0000u)};
                *p = pack8_bf16(x0 + g0 * acc[ai][bj][m][0] * scale, x1 + g1 * acc[ai][bj][m][1] * scale); }
        EPI_LOOP_END
    }
};
struct EpiPartial {
    static constexpr bool PERM = false;
    float* PART;
    DI void operator()(const f32x4 (&acc)[2][2][4][2], const Unit& u, int wr, int wc, int fr, int fq) const {
        const int pn = u.pn & 3, ks = u.pn >> 2;
        EPI_LOOP_BEGIN
#pragma unroll
            for (int bj = 0; bj < 2; ++bj)
#pragma unroll
                for (int n = 0; n < 2; ++n) *(f32x4*)(PART + ((size_t)ks * NCTXR + row) * DM + pn * 256 + bj * 128 + wc * 32 + n * 16 + 4 * fq) = acc[ai][bj][m][n];
        EPI_LOOP_END
    }
};
struct EpiRkvl {
    static constexpr bool PERM = true;
    h16* RKV; bf16_t* TWA; bf16_t* TG;
    DI void operator()(const f32x4 (&acc)[2][2][4][2], const Unit& u, int wr, int wc, int fr, int fq) const {
        EPI_LOOP_BEGIN
            const int c8 = wc * 32 + 8 * fq;
            if (u.pn < 12) { h16* dst = RKV + (size_t)(u.pn >> 2) * ROWB + (size_t)row * DM + (u.pn & 3) * 256 + c8;
#pragma unroll
                for (int bj = 0; bj < 2; ++bj) *(h16x8*)(dst + bj * 128) = pack8_h16(acc[ai][bj][m][0], acc[ai][bj][m][1]);
            } else if (u.pn == 12) { f32x4 a = acc[ai][0][m][0], b = acc[ai][0][m][1];
#pragma unroll
                for (int q = 0; q < 4; ++q) { a[q] = tanh_f(a[q]); b[q] = tanh_f(b[q]); }
                *(u32x4*)(TWA + (size_t)row * 256 + c8) = pack8_bf16(a, b);
            } else if (u.pn == 13) { *(u32x4*)(TWA + (size_t)row * 256 + 128 + c8) = pack8_bf16(acc[ai][0][m][0], acc[ai][0][m][1]);
            } else { f32x4 a = acc[ai][0][m][0], b = acc[ai][0][m][1];
#pragma unroll
                for (int q = 0; q < 4; ++q) { a[q] = sigmoid_f(a[q]); b[q] = sigmoid_f(b[q]); }
                *(u32x4*)(TG + (size_t)row * 256 + c8) = pack8_bf16(a, b); *(u32x4*)(TG + (size_t)row * 256 + 128 + c8) = (u32x4){0x3f003f00u, 0x3f003f00u, 0x3f003f00u, 0x3f003f00u}; }
        EPI_LOOP_END
    }
};
struct EpiLora2 {
    static constexpr bool PERM = true;
    h16* EA; bf16_t* Gm; const float* w0; const float* a0;
    DI void operator()(const f32x4 (&acc)[2][2][4][2], const Unit& u, int wr, int wc, int fr, int fq) const {
        const int seg = u.pn >> 3, dir = (u.pn >> 2) & 1, colt = (u.pn & 3) * 256;
#pragma unroll
        for (int bj = 0; bj < 2; ++bj) {
            const int col = colt + bj * 128 + wc * 32 + 8 * fq;
            f32x4 wa = (f32x4){0.f, 0.f, 0.f, 0.f}, wb = wa;
            if (seg < 2) { const float* bp = (seg == 0 ? w0 : a0) + dir * 1024 + col; wa = *(const f32x4*)bp; wb = *(const f32x4*)(bp + 4); }
            h16* eo = EA + (size_t)(2 * seg + dir) * ROWB + col;
#pragma unroll
            for (int ai = 0; ai < 2; ++ai)
#pragma unroll
                for (int m = 0; m < 4; ++m) {
                    const int row = u.pm * 256 + ai * 128 + wr * 64 + m * 16 + fr;
                    f32x4 a = acc[ai][bj][m][0] + wa, b = acc[ai][bj][m][1] + wb;
                    if (seg == 0) { a = decay_e4(a); b = decay_e4(b); *(h16x8*)(eo + (size_t)row * DM) = pack8_h16(a, b); }
                    else if (seg == 1) { a = sigmoid4(a); b = sigmoid4(b); *(h16x8*)(eo + (size_t)row * DM) = pack8_h16(a, b); }
                    else *(u32x4*)(Gm + (size_t)row * DM + col) = pack8_bf16(a, b);
                    __builtin_amdgcn_sched_barrier(0);
                }
        }
    }
};
struct EpiMoe1 {
    static constexpr bool PERM = true;
    bf16_t* H;
    DI void operator()(const f32x4 (&acc)[2][2][4][2], const Unit& u, int wr, int wc, int fr, int fq) const {
        EPI_LOOP_BEGIN
            f32x4 a = acc[ai][0][m][0], b = acc[ai][0][m][1]; const f32x4 a3 = acc[ai][1][m][0], b3 = acc[ai][1][m][1];
#pragma unroll
            for (int q = 0; q < 4; ++q) { a[q] = silu_f(a[q]) * a3[q]; b[q] = silu_f(b[q]) * b3[q]; }
            *(u32x4*)(H + (size_t)row * DEXP + u.pn * 128 + wc * 32 + 8 * fq) = pack8_bf16(a, b);
        EPI_LOOP_END
    }
};
struct EpiMoe2 {
    static constexpr bool PERM = true;
    bf16_t* Y;
    DI void operator()(const f32x4 (&acc)[2][2][4][2], const Unit& u, int wr, int wc, int fr, int fq) const {
        EPI_LOOP_BEGIN
#pragma unroll
            for (int bj = 0; bj < 2; ++bj) *(u32x4*)(Y + (size_t)row * DM + u.pn * 256 + bj * 128 + wc * 32 + 8 * fq) = pack8_bf16(acc[ai][bj][m][0], acc[ai][bj][m][1]);
        EPI_LOOP_END
    }
};

DI int crow(int i, int hi) { return (i & 3) + 8 * (i >> 2) + 4 * hi; }

namespace attn_dense {
using bf16=unsigned short;
constexpr int D=64,DMQ=1024,NTILES=132;
constexpr int NW=8,QBLK=32,QB=QBLK*NW,KVBLK=64;
#define SBAR() __builtin_amdgcn_sched_barrier(0)
constexpr int NSLOT=3, SLOTB=8192;
constexpr int LDS_K=0, LDS_V=NSLOT*SLOTB, LDS_WS=2*NSLOT*SLOTB, LDS_OST=LDS_WS+NW*64*4, LDS_BYTES=LDS_OST+NW*4096;
constexpr float C2=0.125f*1.4426950408889634f;
__device__ __forceinline__ void glds16(const void*gsrc,unsigned lds_dst){unsigned keep;
  asm volatile("s_mov_b32 %0, m0\n\ts_mov_b32 m0, %2\n\ts_nop 0\n\tglobal_load_lds_dwordx4 %1, off\n\ts_mov_b32 m0, %0":"=&s"(keep):"v"(gsrc),"s"(lds_dst):"memory");}
__device__ __forceinline__ float max3f(float a,float b,float c){float r;asm("v_max3_f32 %0, %1, %2, %3":"=v"(r):"v"(a),"v"(b),"v"(c));return r;}
__device__ __forceinline__ float max2f(float a,float b){float r;asm("v_max_f32_e32 %0, %1, %2":"=v"(r):"v"(a),"v"(b));return r;}
__device__ __forceinline__ float fadd_s(float a,float b){float r;asm("v_add_f32_e32 %0, %1, %2":"=v"(r):"v"(a),"v"(b));return r;}
__device__ __forceinline__ float fsub_s(float a,float b){float r;asm("v_sub_f32_e32 %0, %1, %2":"=v"(r):"v"(a),"v"(b));return r;}
typedef float f32x2_t __attribute__((ext_vector_type(2)));
__device__ __forceinline__ unsigned cvtpk_s(float lo,float hi){f32x2_t v={lo,hi};bf16x2_t b=__builtin_convertvector(v,bf16x2_t);return __builtin_bit_cast(unsigned,b);}
#define WAIT_BAR(N) asm volatile("s_waitcnt vmcnt(" #N ") lgkmcnt(0)\n\ts_barrier":::"memory")

__device__ __forceinline__ void qkt(f32x16&p0,f32x16&p1,const char*Kslot,const bf16x8*qr,const f32x16&negm,int r32,int hi){
  const char*kb=Kslot+hi*1024+r32*16;
  #pragma unroll
  for(int d0=0;d0<4;++d0){
    const bf16x8 b0=*reinterpret_cast<const bf16x8*>(kb+d0*2048);
    const bf16x8 b1=*reinterpret_cast<const bf16x8*>(kb+d0*2048+512);
    if(d0==0){p0=__builtin_amdgcn_mfma_f32_32x32x16_bf16(b0,qr[0],negm,0,0,0);p1=__builtin_amdgcn_mfma_f32_32x32x16_bf16(b1,qr[0],negm,0,0,0);}
    else{p0=__builtin_amdgcn_mfma_f32_32x32x16_bf16(b0,qr[d0],p0,0,0,0);p1=__builtin_amdgcn_mfma_f32_32x32x16_bf16(b1,qr[d0],p1,0,0,0);}}
}
typedef __attribute__((address_space(3))) const char* lds_cptr;
typedef short v4i16_t __attribute__((ext_vector_type(4)));
__device__ __forceinline__ void kload8(bf16x8*kf,lds_cptr kp){
  kf[0]=*(const __attribute__((address_space(3))) bf16x8*)(kp);      kf[1]=*(const __attribute__((address_space(3))) bf16x8*)(kp+512);
  kf[2]=*(const __attribute__((address_space(3))) bf16x8*)(kp+2048); kf[3]=*(const __attribute__((address_space(3))) bf16x8*)(kp+2560);
  kf[4]=*(const __attribute__((address_space(3))) bf16x8*)(kp+4096); kf[5]=*(const __attribute__((address_space(3))) bf16x8*)(kp+4608);
  kf[6]=*(const __attribute__((address_space(3))) bf16x8*)(kp+6144); kf[7]=*(const __attribute__((address_space(3))) bf16x8*)(kp+6656);
}
__device__ __forceinline__ void kload2(bf16x8*kf,lds_cptr kp,int j){ kf[2*j]=*(const __attribute__((address_space(3))) bf16x8*)(kp+j*2048); kf[2*j+1]=*(const __attribute__((address_space(3))) bf16x8*)(kp+j*2048+512); }
__device__ __forceinline__ s16x4 vtr(lds_cptr p){ return __builtin_bit_cast(s16x4,__builtin_amdgcn_ds_read_tr16_b64_v4i16((__attribute__((address_space(3))) v4i16_t*)p)); }
__device__ __forceinline__ float rowmax(const f32x16&p0,const f32x16&p1){
  float a=max3f(p0[0],p0[1],p1[0]),b=max3f(p0[2],p0[3],p1[1]);a=max3f(a,p1[2],p1[3]);
  #pragma unroll
  for(int r=4;r<16;r+=4){a=max3f(a,p0[r],p0[r+1]);b=max3f(b,p0[r+2],p0[r+3]);a=max3f(a,p1[r],p1[r+1]);b=max3f(b,p1[r+2],p1[r+3]);}
  const float m=max2f(a,b);
  auto rr=__builtin_amdgcn_permlane32_swap(__float_as_uint(m),__float_as_uint(m),false,false);
  return max2f(__uint_as_float(rr[0]),__uint_as_float(rr[1]));
}
__device__ __forceinline__ void pv(f32x16*o,int vb,bf16x8 pa0,bf16x8 pa1,bf16x8 pa2,bf16x8 pa3){
  #pragma unroll
  for(int d0=0;d0<2;++d0){s16x4 lo[4],hi[4];
    #pragma unroll
    for(int ks=0;ks<4;++ks){
      asm volatile("ds_read_b64_tr_b16 %0,%1 offset:%c2":"=&v"(lo[ks]):"v"(vb),"i"(d0*4096+ks*1024):"memory");
      asm volatile("ds_read_b64_tr_b16 %0,%1 offset:%c2":"=&v"(hi[ks]):"v"(vb),"i"(d0*4096+ks*1024+512):"memory");}
    asm volatile("s_waitcnt lgkmcnt(0)":::"memory");SBAR();
    #define PK(k) (bf16x8){lo[k][0],lo[k][1],lo[k][2],lo[k][3],hi[k][0],hi[k][1],hi[k][2],hi[k][3]}
    o[d0]=__builtin_amdgcn_mfma_f32_32x32x16_bf16(pa0,PK(0),o[d0],0,0,0);
    o[d0]=__builtin_amdgcn_mfma_f32_32x32x16_bf16(pa1,PK(1),o[d0],0,0,0);
    o[d0]=__builtin_amdgcn_mfma_f32_32x32x16_bf16(pa2,PK(2),o[d0],0,0,0);
    o[d0]=__builtin_amdgcn_mfma_f32_32x32x16_bf16(pa3,PK(3),o[d0],0,0,0);
    #undef PK
  }
}

#ifndef ATTN_STORE16
#define ATTN_STORE16(p,v) (*(u32x4*)(p)=(v))
#endif
__device__ __forceinline__ void wmask(f32x16&p0,f32x16&p1,int kp0,int qpos,int hi){
  const float NEG=-INFINITY; const int kb=kp0+4*hi;
  #pragma unroll
  for(int r=0;r<16;++r){const int kv=kb+(r&3)+8*(r>>2); int d0=qpos-kv; d0=d0<0?-d0:d0; int d1=qpos-kv-32; d1=d1<0?-d1:d1; if(d0>128)p0[r]=NEG; if(d1>128)p1[r]=NEG;}
}
template<int THRL,int KVP,bool WIN> __device__ __forceinline__ void attn_unit(int qrow0,int kvrow0,int h,int kvh,const bf16*Q,const bf16*__restrict__ K,const bf16*__restrict__ V,bf16*O,char*shm,int nt_arg,int wlo,int qpos0,float sink2,const int tid){
  const int lane=tid&63,r32=lane&31,hi=lane>>5; const int wid=__builtin_amdgcn_readfirstlane(tid>>6);
  const bf16*Qw=Q+((long)qrow0+wid*QBLK)*DMQ+h*D;
  const bf16*Kh=K+(long)kvrow0*KVP+kvh*D,*Vh=V+(long)kvrow0*KVP+kvh*D;
  const unsigned lds0=(unsigned)(uintptr_t)shm;
  float*wsf=(float*)(shm+LDS_WS)+wid*64;
  const bf16*ksrc=Kh+(long)lane*KVP+wid*8;
  const bf16*vsrc=Vh+(long)(16*(wid&3)+(lane>>2))*KVP+(wid>>2)*32+(lane&3)*8;
  const unsigned kdst=lds0+LDS_K+wid*1024, vdst=lds0+LDS_V+wid*1024;
  #define TROW(t) (WIN ? ((t)<4 ? 64*(t) : 256+wlo+64*((t)-4)) : 64*(t))
  #define DMA_K(t,slot) glds16(ksrc+(long)TROW(t)*KVP,(unsigned)__builtin_amdgcn_readfirstlane(kdst+(slot)))
  #define DMA_V(t,slot) glds16(vsrc+(long)TROW(t)*KVP,(unsigned)__builtin_amdgcn_readfirstlane(vdst+(slot)))
  const int vb0=(int)(lds0+LDS_V)+((lane>>4)&1)*32+(lane&3)*8+(4*hi+((lane&15)>>2))*64;
  const char*Kbase=shm+LDS_K; bf16x8 kf[8];
  const lds_cptr shm3=(lds_cptr)shm; const lds_cptr kp0=shm3+LDS_K+hi*1024+r32*16; const lds_cptr vp0=shm3+LDS_V+((lane>>4)&1)*32+(lane&3)*8+(4*hi+((lane&15)>>2))*64;
  const int NT=nt_arg;
  const int qpos=qpos0+wid*QBLK+r32;
  DMA_K(0,0);DMA_V(0,0);DMA_K(1,SLOTB);
  bf16x8 qr[4];
  #pragma unroll
  for(int d0=0;d0<4;++d0)qr[d0]=*reinterpret_cast<const bf16x8*>(&Qw[(long)r32*DMQ+d0*16+hi*8]);
  float mhat=0.f,l_reg=0.f;f32x16 o[2];o[0]=f32x16{};o[1]=f32x16{};f32x16 negm=f32x16{};asm volatile("":"+v"(negm));
  #define CMASK(P0,P1,t) do{ if(WIN && (t)>=4) wmask(P0,P1,wlo+64*((t)-4),qpos,hi); }while(0)
  bool resc=false;
  #define START(P0,P1) do{ const float rm=rowmax(P0,P1); resc=false; \
    { const float dl=rm; mhat=fadd_s(mhat,dl); \
      _Pragma("unroll") for(int r=0;r<16;++r){P0[r]=fsub_s(P0[r],dl);P1[r]=fsub_s(P1[r],dl);} \
      _Pragma("unroll") for(int r=0;r<16;++r)negm[r]=-mhat; asm volatile("":"+v"(negm)); } \
    _Pragma("unroll") for(int r=0;r<16;++r)P0[r]=__builtin_amdgcn_exp2f(P0[r]); }while(0)
  #define RESC() do{ if(resc){ asm volatile("s_waitcnt lgkmcnt(0)":::"memory"); \
      _Pragma("unroll") for(int d_=0;d_<2;++d_) _Pragma("unroll") for(int r=0;r<16;++r)o[d_][r]*=wsf[crow(r,hi)]; } }while(0)
  f32x16 pA0,pA1,pB0,pB1;
  int sl_prev=0,sl_cur=0,sl_next=SLOTB;
  #define ROT() do{sl_prev=sl_cur;sl_cur=sl_next;sl_next=(sl_next==(NSLOT-1)*SLOTB)?0:sl_next+SLOTB;}while(0)
  DMA_K(2,2*SLOTB);
  WAIT_BAR(3);
  qkt(pA0,pA1,Kbase,qr,negm,r32,hi);asm volatile("s_nop 15\n\ts_nop 7":"+v"(pA0),"+v"(pA1));CMASK(pA0,pA1,0);
  START(pA0,pA1);
  _Pragma("unroll") for(int r=0;r<16;++r)pA1[r]=__builtin_amdgcn_exp2f(pA1[r]);
  WAIT_BAR(0);
  DMA_K(3,0);DMA_V(1,SLOTB);
  ROT();
  kload8(kf,kp0+sl_cur);
  WAIT_BAR(2);
  s16x4 vlo[8],vhi[8]; u32x4 pw0,pw1,pw2,pw3;
  #define PKW(P,B) cvtpk_s(P[B],P[B+1])
  #define PAF(k) __builtin_bit_cast(bf16x8,pw##k)
  #define VFR(i) (bf16x8){vlo[i][0],vlo[i][1],vlo[i][2],vlo[i][3],vhi[i][0],vhi[i][1],vhi[i][2],vhi[i][3]}
  #define PIN(x) asm volatile("":"+v"(x))
  #define MX3(a,b,c) __builtin_fmaxf(__builtin_fmaxf((a),(b)),(c))
  #define GAPA(MF,A0,A1,A2,A3,W0,W1,PW) do{ MF; sacc+=A0; sacc+=A1; sacc+=A2; sacc+=A3; PIN(sacc); W0; W1; PIN(PW); SBAR(); }while(0)
  #define EX(v) __builtin_amdgcn_exp2f(v)
  #define GAPB(MF,X,B) do{ MF; X[B]=EX(X[B]); X[B+1]=EX(X[B+1]); X[B+2]=EX(X[B+2]); X[B+3]=EX(X[B+3]); PIN(X); SBAR(); }while(0)
  #define VRD(i) do{ vlo[i]=vtr(vp_+(((i)>>2)*4096+((i)&3)*1024)); vhi[i]=vtr(vp_+(((i)>>2)*4096+((i)&3)*1024+512)); }while(0)
  #define KRD(G,j) do{ if(G){ kload2(kf,kp0+sl_next,j); SBAR(); } }while(0)
  #define STEP(C0,C1,P0,P1,t,GK,GV,GL) do{ SBAR(); \
    const lds_cptr vp_=vp0+sl_prev; \
    VRD(0); SBAR(); float sacc=(P0[0]+P0[1]); \
    GAPA(C0=__builtin_amdgcn_mfma_f32_32x32x16_bf16(kf[0],qr[0],negm,0,0,0), P0[2],P0[3],P0[4],P0[5],     pw0[0]=PKW(P0,0), pw0[1]=PKW(P0,2), pw0); \
    VRD(4); SBAR(); GAPA(C1=__builtin_amdgcn_mfma_f32_32x32x16_bf16(kf[1],qr[0],negm,0,0,0), P0[6],P0[7],P0[8],P0[9],     pw0[2]=PKW(P0,4), pw0[3]=PKW(P0,6), pw0); \
    VRD(1); SBAR(); GAPA(C0=__builtin_amdgcn_mfma_f32_32x32x16_bf16(kf[2],qr[1],C0,0,0,0),   P0[10],P0[11],P0[12],P0[13], pw1[0]=PKW(P0,8), pw1[1]=PKW(P0,10), pw1); \
    VRD(5); SBAR(); GAPA(C1=__builtin_amdgcn_mfma_f32_32x32x16_bf16(kf[3],qr[1],C1,0,0,0),   P0[14],P0[15],P1[0],P1[1],   pw1[2]=PKW(P0,12),pw1[3]=PKW(P0,14), pw1); \
    VRD(2); SBAR(); GAPA(C0=__builtin_amdgcn_mfma_f32_32x32x16_bf16(kf[4],qr[2],C0,0,0,0),   P1[2],P1[3],P1[4],P1[5],     pw2[0]=PKW(P1,0), pw2[1]=PKW(P1,2), pw2); \
    VRD(6); SBAR(); GAPA(C1=__builtin_amdgcn_mfma_f32_32x32x16_bf16(kf[5],qr[2],C1,0,0,0),   P1[6],P1[7],P1[8],P1[9],     pw2[2]=PKW(P1,4), pw2[3]=PKW(P1,6), pw2); \
    VRD(3); SBAR(); GAPA(C0=__builtin_amdgcn_mfma_f32_32x32x16_bf16(kf[6],qr[3],C0,0,0,0),   P1[10],P1[11],P1[12],P1[13], pw3[0]=PKW(P1,8), pw3[1]=PKW(P1,10), pw3); \
    VRD(7); SBAR(); GAPA(C1=__builtin_amdgcn_mfma_f32_32x32x16_bf16(kf[7],qr[3],C1,0,0,0),   P1[14],P1[15],0.f,0.f,       pw3[2]=PKW(P1,12),pw3[3]=PKW(P1,14), pw3); \
    l_reg+=sacc; \
    if(GK){DMA_K((t)+3,sl_cur);} if(GV){DMA_V((t)+1,sl_next);} \
    CMASK(C0,C1,t); \
    { float a=MX3(C0[0],C0[1],C1[0]),b=MX3(C0[2],C0[3],C1[1]); a=MX3(a,C1[2],C1[3]); \
      _Pragma("unroll") for(int r=4;r<16;r+=4){a=MX3(a,C0[r],C0[r+1]);b=MX3(b,C0[r+2],C0[r+3]);a=MX3(a,C1[r],C1[r+1]);b=MX3(b,C1[r+2],C1[r+3]);} \
      float rm=__builtin_fmaxf(a,b); { auto rr=__builtin_amdgcn_permlane32_swap(__float_as_uint(rm),__float_as_uint(rm),false,false); rm=__builtin_fmaxf(__uint_as_float(rr[0]),__uint_as_float(rr[1])); } \
      resc=false; \
      if(__builtin_expect(__any(rm>(float)THRL),0)){ const float dl=__builtin_fmaxf(rm,0.f); mhat+=dl; \
        _Pragma("unroll") for(int r=0;r<16;++r){C0[r]-=dl;C1[r]-=dl;} \
        _Pragma("unroll") for(int r=0;r<16;++r)negm[r]=-mhat; asm volatile("":"+v"(negm)); \
        const float f=__builtin_amdgcn_exp2f(-dl); l_reg*=f; if(hi==0)wsf[r32]=f; resc=true; } } \
    SBAR(); \
    GAPB(o[0]=__builtin_amdgcn_mfma_f32_32x32x16_bf16(PAF(0),VFR(0),o[0],0,0,0), C0,0); \
    GAPB(o[1]=__builtin_amdgcn_mfma_f32_32x32x16_bf16(PAF(0),VFR(4),o[1],0,0,0), C0,4); \
    KRD(GL,0); GAPB(o[0]=__builtin_amdgcn_mfma_f32_32x32x16_bf16(PAF(1),VFR(1),o[0],0,0,0), C0,8); \
    KRD(GL,1); GAPB(o[1]=__builtin_amdgcn_mfma_f32_32x32x16_bf16(PAF(1),VFR(5),o[1],0,0,0), C0,12); \
    KRD(GL,2); GAPB(o[0]=__builtin_amdgcn_mfma_f32_32x32x16_bf16(PAF(2),VFR(2),o[0],0,0,0), C1,0); \
    KRD(GL,3); GAPB(o[1]=__builtin_amdgcn_mfma_f32_32x32x16_bf16(PAF(2),VFR(6),o[1],0,0,0), C1,4); \
    GAPB(o[0]=__builtin_amdgcn_mfma_f32_32x32x16_bf16(PAF(3),VFR(3),o[0],0,0,0), C1,8); \
    GAPB(o[1]=__builtin_amdgcn_mfma_f32_32x32x16_bf16(PAF(3),VFR(7),o[1],0,0,0), C1,12); \
    }while(0)
  int t=1;
  #undef CMASK
  #define CMASK(P0,P1,t) do{ if(WIN && (t)>=4) wmask(P0,P1,wlo+64*((t)-4),qpos,hi); }while(0)
  for(;t+5<NT;t+=2){
    STEP(pB0,pB1,pA0,pA1,t,true,true,true);     WAIT_BAR(2); RESC(); ROT();
    STEP(pA0,pA1,pB0,pB1,t+1,true,true,true);   WAIT_BAR(2); RESC(); ROT();
  }
  #undef CMASK
  #define CMASK(P0,P1,t) do{ if(WIN && (t)>=4) wmask(P0,P1,wlo+64*((t)-4),qpos,hi); }while(0)
  #define ENDW(tt) do{ if((tt)+3<NT){WAIT_BAR(2);} else if((tt)+2<NT){WAIT_BAR(1);} else {WAIT_BAR(0);} }while(0)
  for(;t+1<NT;t+=2){
    STEP(pB0,pB1,pA0,pA1,t,(t+3<NT),(t+1<NT),(t+1<NT));       ENDW(t);   RESC(); ROT();
    STEP(pA0,pA1,pB0,pB1,t+1,(t+4<NT),(t+2<NT),(t+2<NT));     ENDW(t+1); RESC(); ROT();
  }
  STEP(pB0,pB1,pA0,pA1,NT-1,false,false,false); RESC();
  { float sacc=pB0[0]+pB0[1]; _Pragma("unroll") for(int r=2;r<16;++r)sacc+=pB0[r]; _Pragma("unroll") for(int r=0;r<16;++r)sacc+=pB1[r]; l_reg+=sacc;
    pw0=(u32x4){PKW(pB0,0),PKW(pB0,2),PKW(pB0,4),PKW(pB0,6)};pw1=(u32x4){PKW(pB0,8),PKW(pB0,10),PKW(pB0,12),PKW(pB0,14)};pw2=(u32x4){PKW(pB1,0),PKW(pB1,2),PKW(pB1,4),PKW(pB1,6)};pw3=(u32x4){PKW(pB1,8),PKW(pB1,10),PKW(pB1,12),PKW(pB1,14)};
    SBAR(); pv(o,vb0+sl_cur,PAF(0),PAF(1),PAF(2),PAF(3)); }
  #undef PKW
  #undef PAF
  #undef VFR
  #undef PIN
  #undef MX3
  #undef GAPA
  #undef GAPB
  #undef EX
  #undef VRD
  #undef KRD
  #undef STEP
  #undef ENDW
  {auto rr=__builtin_amdgcn_permlane32_swap(__float_as_uint(l_reg),__float_as_uint(l_reg),false,false);l_reg=__uint_as_float(rr[0])+__uint_as_float(rr[1]);}
  if(WIN) l_reg+=__builtin_amdgcn_exp2f(sink2-mhat);
  if(hi==0)wsf[32+r32]=l_reg;asm volatile("s_waitcnt lgkmcnt(0)":::"memory");
  float rli[16];
  #pragma unroll
  for(int r=0;r<16;++r)rli[r]=__builtin_amdgcn_rcpf(wsf[32+crow(r,hi)]);
  bf16*Ow=O+((long)qrow0+wid*QBLK)*DMQ+h*D;
  { bf16*stg=(bf16*)(shm+LDS_OST)+wid*2048;
    #pragma unroll
    for(int r=0;r<16;++r){const int orow=crow(r,hi);
      #pragma unroll
      for(int d0=0;d0<2;++d0)stg[orow*64+d0*32+r32]=(bf16)(cvtpk_s(o[d0][r]*rli[r],0.f)&0xffffu);}
    asm volatile("s_waitcnt lgkmcnt(0)":::"memory");
    #pragma unroll
    for(int i=0;i<4;++i){const int row=i*8+(lane>>3),ch=lane&7; const u32x4 v=*(const u32x4*)(stg+row*64+ch*8); ATTN_STORE16(Ow+(long)row*DMQ+ch*8,v);} }
  asm volatile("s_waitcnt lgkmcnt(0)\n\ts_barrier":::"memory");
  #undef DMA_K
  #undef TROW
  #undef DMA_V
  #undef CMASK
  #undef START
  #undef RESC
  #undef ROT
}
#undef SBAR
#undef WAIT_BAR
}

DI void phase_attention(const Ctx& P, bool dense, int j, bool with_ctx, LAS unsigned char* lds, int tid, int lane, int wave) {
    unsigned char* ws = P.ws;
    const bf16_t* Q = (const bf16_t*)(ws + WS_Q); const bf16_t* K = (const bf16_t*)(ws + WS_K); const bf16_t* V = (const bf16_t*)(ws + WS_V); bf16_t* O = (bf16_t*)(ws + WS_O);
    const int nunits = 1024 + (with_ctx ? 32 : 0);
    const float* sinkp = P.in(I_CSINK);
    const int G = gridDim.x, bx = blockIdx.x, vcu = (G % 8 == 0) ? (bx % 8) * (G / 8) + bx / 8 : bx;
    for (int u = vcu; u < nunits; u += G) {
        const bool ctxu = u >= 1024;
        const int bh = ctxu ? u - 1024 : u >> 5, qt = u & 31, b = bh >> 4, h = bh & 15, q0 = qt * 256;
        const int qrow0 = ctxu ? b * NCTX : NCTXR + b * SEQ + q0;
        if (dense) attn_dense::attn_unit<8, 256, false>(qrow0, b * KVLEN, h, h >> 2, Q, K, V, O, (char*)lds, ctxu ? 4 : KVLEN / 64, 0, 0, 0.f, tid);
        else { const int lo = q0 - 128 < 0 ? 0 : q0 - 128, hi_ = q0 + 384 > SEQ ? SEQ : q0 + 384;
            attn_dense::attn_unit<8, 128, true>(qrow0, b * KVLEN, h, h >> 3, Q, K, V, O, (char*)lds, ctxu ? 4 : 4 + (hi_ - lo) / 64, lo, q0, sinkp[h] * LOG2E, tid); }
    }
    __syncthreads();
    (void)j; (void)lane; (void)wave;
}

DI int tseq_of(int dir, bool lat, int t) { return lat ? NCTX + (dir ? (SEQ - 1 - t) : t) : (dir ? (NCTX - 1 - t) : t); }
DI void ld16h(const h16* p, float (&v)[16]) { const h16x8 a = ((const h16x8*)p)[0], b = ((const h16x8*)p)[1];
#pragma unroll
    for (int i = 0; i < 8; ++i) { v[i] = (float)a[i]; v[8 + i] = (float)b[i]; } }
DI void st16h(h16* p, const float (&v)[16]) { h16x8 a, b;
#pragma unroll
    for (int i = 0; i < 8; ++i) { a[i] = (h16)v[i]; b[i] = (h16)v[8 + i]; }
    ((h16x8*)p)[0] = a; ((h16x8*)p)[1] = b; }
constexpr int SCN_T = 32, SCN_R16 = 0, SCN_KD16 = SCN_T * 128, SCN_KK16 = 2 * SCN_T * 128, SCN_BB16 = 3 * SCN_T * 128, SCN_W32 = 4 * SCN_T * 128, SCN_V32 = SCN_W32 + SCN_T * 256, SCN_OPB = SCN_V32 + SCN_T * 16 * 4  ,
              SCN_YP0 = 2 * SCN_OPB, SCN_YPB = (SCN_T / 2) * 1024  , SCN_CONV = SCN_YP0 + 2 * SCN_YPB;
struct ScanOps { u32x2 r, kd, kk, bb; f32x4 w; float v; };
DI void scan_ld(ScanOps& o, const LAS unsigned char* base, int t, int kc, int rowl) {
    const LAS unsigned char* p = base + t * 128 + 8 * kc;
    o.r = *(const LAS u32x2*)(p + SCN_R16); o.kd = *(const LAS u32x2*)(p + SCN_KD16); o.kk = *(const LAS u32x2*)(p + SCN_KK16); o.bb = *(const LAS u32x2*)(p + SCN_BB16);
    o.w = *(const LAS f32x4*)(base + SCN_W32 + t * 256 + 16 * kc);
    (void)rowl;
}
DI int scan_row(int dir, int b, int ts) { if (ts < NCTX) return b * NCTX + (dir ? NCTX - 1 - ts : ts); const int tl = ts - NCTX; return NCTXR + b * SEQ + (dir ? SEQ - 1 - tl : tl); }
DI void phase_rwkv_scan(const Ctx& P, LAS unsigned char* lds, int tid, int lane, int wave) {
    unsigned char* ws = P.ws;
    const h16* Vm = (const h16*)(ws + WS_RKV16) + 2 * ROWB; bf16_t* YS = (bf16_t*)(ws + WS_YS);
    constexpr int NCH = KVLEN / SCN_T;
    for (int u = blockIdx.x; u < 256; u += gridDim.x) {
        const int grp = u >> 2, rq = u & 3, dir = grp >> 5, b = (grp >> 4) & 1, head = grp & 15;
        __syncthreads();
#define SCN_BAR() asm volatile("s_waitcnt lgkmcnt(0)\n\ts_barrier" ::: "memory")
        if (wave >= 4) {
            const int lt = tid - 256, st = lt >> 3, sg = lt & 7, scol = head * 64 + 8 * sg;
            const h16* Rm = (const h16*)(ws + WS_RKV16); const h16* EAm = (const h16*)(ws + WS_EA16); float* BON = (float*)(ws + WS_BONUS2);
            float ckk[8], cka[8], crk[8];
            { const float* p0 = P.in(I_BKK) + scol; const float* p1 = P.in(I_BKA) + scol; const float* p2 = P.in(I_BRK) + scol;
#pragma unroll
              for (int i = 0; i < 8; ++i) { ckk[i] = p0[i]; cka[i] = p1[i]; crk[i] = p2[i]; } }
            u32x4 preA[4], preB[4]; u32x4 prevA, prevB; int prowA = 0, prowB = 0;
#define SCN_ISSUE(S, chunk) do { prow##S = scan_row(dir, b, (chunk) * SCN_T + st); const size_t ro = (size_t)prow##S * DM + scol; \
                pre##S[0] = *(const u32x4*)(Rm + ro); pre##S[1] = *(const u32x4*)(Rm + ROWB + ro); pre##S[2] = *(const u32x4*)(EAm + (size_t)dir * ROWB + ro); pre##S[3] = *(const u32x4*)(EAm + (size_t)(2 + dir) * ROWB + ro); \
                prev##S = *(const u32x4*)(Vm + (size_t)scan_row(dir, b, (chunk) * SCN_T + ((lt & 63) >> 1)) * DM + head * 64 + rq * 16 + (lt & 1) * 8); } while (0)
#define SCN_COMMIT(S, bufp) do { LAS unsigned char* bq = (LAS unsigned char*)(bufp); LAS unsigned char* b16 = bq + st * 128 + sg * 16; \
                const h16x8 hr = __builtin_bit_cast(h16x8, pre##S[0]), hk = __builtin_bit_cast(h16x8, pre##S[1]), he = __builtin_bit_cast(h16x8, pre##S[2]), ha = __builtin_bit_cast(h16x8, pre##S[3]); \
                float kkr[8]; float n2 = 0.f; \
                _Pragma("unroll") for (int z = 0; z < 8; ++z) { kkr[z] = (float)hk[z] * ckk[z]; n2 += kkr[z] * kkr[z]; } \
                n2 = dpp_add<0xB1>(n2); n2 = dpp_add<0x4E>(n2); n2 = dpp_add<0x141>(n2); \
                const float rn = 1.0f / fmaxf(sqrtf(n2), 1e-12f); float bon = 0.f; \
                f32x4 o_w[2]; h16x8 o_kd, o_kk, o_bb; \
                _Pragma("unroll") for (int z = 0; z < 8; ++z) { const float r_ = (float)hr[z], k_ = (float)hk[z], a_ = (float)ha[z]; const float kk_ = kkr[z] * rn, kd_ = k_ * (1.0f + (a_ - 1.0f) * cka[z]); \
                    o_w[z >> 2][z & 3] = 1.0f - (float)he[z]; o_kd[z] = (h16)kd_; o_kk[z] = (h16)kk_; o_bb[z] = (h16)(-kk_ * a_); bon += r_ * kd_ * crk[z]; } \
                bon = dpp_add<0xB1>(bon); bon = dpp_add<0x4E>(bon); bon = dpp_add<0x141>(bon); \
                if (sg == 0 && rq == 0) BON[((size_t)dir * MROWS + prow##S) * 16 + head] = bon; \
                *(LAS u32x4*)(b16 + SCN_R16) = pre##S[0]; *(LAS u32x4*)(b16 + SCN_KD16) = __builtin_bit_cast(u32x4, o_kd); *(LAS u32x4*)(b16 + SCN_KK16) = __builtin_bit_cast(u32x4, o_kk); *(LAS u32x4*)(b16 + SCN_BB16) = __builtin_bit_cast(u32x4, o_bb); \
                *(LAS f32x4*)(bq + SCN_W32 + st * 256 + sg * 32) = o_w[0]; *(LAS f32x4*)(bq + SCN_W32 + st * 256 + sg * 32 + 16) = o_w[1]; \
                if (lt < 64) { const h16x8 hv = __builtin_bit_cast(h16x8, prev##S); LAS float* d = (LAS float*)(bq + SCN_V32) + (lt & 1) * 8 * SCN_T + (lt >> 1); \
                    _Pragma("unroll") for (int z = 0; z < 8; ++z) d[z * SCN_T] = (float)hv[z]; } } while (0)
#define SCN_YOUT(chunk) do { const int m_ = lt >> 4, row_ = lt & 15; \
                const LAS u32x4* yp_ = (const LAS u32x4*)(lds + SCN_YP0 + ((chunk) & 1) * SCN_YPB + m_ * 1024 + row_ * 64); \
                float ya_ = 0.f, yb_ = 0.f; \
                _Pragma("unroll") for (int q_ = 0; q_ < 4; ++q_) { const u32x4 w_ = yp_[q_]; \
                    _Pragma("unroll") for (int z_ = 0; z_ < 4; ++z_) { ya_ += __uint_as_float(w_[z_] << 16); yb_ += __uint_as_float(w_[z_] & 0xffff0000u); } } \
                const float na_ = dpp_mov<0xB1>(ya_), nb_ = dpp_mov<0xB1>(yb_);     \
                const unsigned pk_ = (row_ & 1) ? cvt_pk_bf16(nb_, yb_) : cvt_pk_bf16(ya_, na_); \
                *(unsigned*)(YS + (size_t)dir * ROWB + (size_t)scan_row(dir, b, (chunk) * SCN_T + 2 * m_ + (row_ & 1)) * DM + head * 64 + rq * 16 + (row_ & ~1)) = pk_; } while (0)
            const int glw = u * 4 + (wave - 4);
            const bool conv = (gridDim.x == 256);
            LAS float* cscr = (LAS float*)(lds + SCN_CONV + (wave - 4) * 8704);
            const float* mw1 = P.in(I_MW1); const float* mw3 = P.in(I_MW3); const float* mw2 = P.in(I_MW2);
            float tv[32]; MoeItem mi; int mldt = 0;
            static_assert((NCH & 1) == 0 && NCH > 116, "chunk schedule");
#define SCN_CVS(c) moe_item_store(mi, mldt, tv, cscr, lane)
#define SCN_CVL(c) do { mi = moe_item_decode(mw1, mw3, mw2, ws, N_MOE_PRO + glw + 1024 * (c), lane, mldt); moe_item_load(mi, tv); } while (0)
            if (conv) {
                SCN_ISSUE(A, 0); SCN_COMMIT(A, lds); SCN_ISSUE(B, 1); SCN_ISSUE(A, 2);
                mi = moe_item_decode(mw1, mw3, mw2, ws, N_MOE_PRO + glw, lane, mldt); moe_item_load(mi, tv);
                SCN_BAR();
                { SCN_CVS(0); SCN_CVL(1); SCN_COMMIT(B, lds + SCN_OPB); SCN_ISSUE(B, 3); SCN_BAR(); }
                { SCN_CVS(1); SCN_CVL(2); SCN_COMMIT(A, lds); SCN_ISSUE(A, 4); SCN_YOUT(0); SCN_BAR(); }
                for (int ch = 2; ch < 106; ch += 2) {
                    { SCN_CVS(ch); SCN_CVL(ch + 1); SCN_COMMIT(B, lds + SCN_OPB); SCN_ISSUE(B, ch + 3); SCN_YOUT(ch - 1); SCN_BAR(); }
                    { SCN_CVS(ch + 1); SCN_CVL(ch + 2); SCN_COMMIT(A, lds); SCN_ISSUE(A, ch + 4); SCN_YOUT(ch); SCN_BAR(); } }
                { SCN_CVS(106); SCN_CVL(107); SCN_COMMIT(B, lds + SCN_OPB); SCN_ISSUE(B, 109); SCN_YOUT(105); SCN_BAR(); }
                { SCN_CVS(107); SCN_COMMIT(A, lds); SCN_ISSUE(A, 110); SCN_YOUT(106); SCN_BAR(); }
                for (int ch = 108; ch < NCH - 4; ch += 2) {
                    { SCN_COMMIT(B, lds + SCN_OPB); SCN_ISSUE(B, ch + 3); SCN_YOUT(ch - 1); SCN_BAR(); }
                    { SCN_COMMIT(A, lds); SCN_ISSUE(A, ch + 4); SCN_YOUT(ch); SCN_BAR(); } }
                { SCN_COMMIT(B, lds + SCN_OPB); SCN_ISSUE(B, NCH - 1); SCN_YOUT(NCH - 5); SCN_BAR(); }
                { SCN_COMMIT(A, lds); SCN_YOUT(NCH - 4); SCN_BAR(); }
                { SCN_COMMIT(B, lds + SCN_OPB); SCN_YOUT(NCH - 3); SCN_BAR(); }
                { SCN_YOUT(NCH - 2); SCN_BAR(); }
            } else {
                SCN_ISSUE(A, 0); SCN_COMMIT(A, lds);
                SCN_BAR();
                for (int ch = 0; ch < NCH; ++ch) {
                    if (ch + 1 < NCH) { SCN_ISSUE(A, ch + 1); SCN_COMMIT(A, lds + ((ch + 1) & 1) * SCN_OPB); }
                    if (ch > 0) SCN_YOUT(ch - 1);
                    SCN_BAR(); }
            }
#undef SCN_CVS
#undef SCN_CVL
            SCN_YOUT(NCH - 1);
#undef SCN_ISSUE
#undef SCN_COMMIT
#undef SCN_YOUT
        } else {
            __builtin_amdgcn_s_setprio(3);
            const int rowl = 4 * wave + (lane >> 4), kc = lane & 15;
            f32x2 S01 = (f32x2){0.f, 0.f}, S23 = (f32x2){0.f, 0.f};
            SCN_BAR();
            for (int ch = 0; ch < NCH; ++ch) {
                const LAS unsigned char* base = lds + (ch & 1) * SCN_OPB;
                LAS unsigned char* ypb = lds + SCN_YP0 + (ch & 1) * SCN_YPB + wave * 256 + lane * 4;
                ScanOps cur, nxt, nn; scan_ld(cur, base, 0, kc, rowl); scan_ld(nxt, base, 1, kc, rowl);
                const LAS float* vrow = (const LAS float*)(base + SCN_V32) + rowl * SCN_T;
                f32x4 vq = *(const LAS f32x4*)vrow, vqn = vq;
                float ye = 0.f;
                u32x2 rp = cur.r;
#define SB_() __builtin_amdgcn_sched_barrier(0)
#pragma unroll
                for (int t = 0; t < SCN_T; ++t) {
                    if (t + 2 < SCN_T) scan_ld(nn, base, t + 2, kc, rowl);
                    if (t + 1 < SCN_T && ((t + 1) & 3) == 0) vqn = *(const LAS f32x4*)(vrow + t + 1);
                    SB_();
                    cur.v = vq[t & 3];
#define MIXL "op_sel:[0,0,0] op_sel_hi:[0,1,0]"
#define MIXH "op_sel:[0,1,0] op_sel_hi:[0,1,0]"
#define MIXL0 "op_sel:[0,0,0] op_sel_hi:[1,0,0]"
#define MIXH0 "op_sel:[1,0,0] op_sel_hi:[1,0,0]"
                    {   float dd, yo; const float vf = vq[t & 3];
                        float s0 = S01[0], s1 = S01[1], s2 = S23[0], s3 = S23[1];
                        asm volatile(
                            "v_fma_mix_f32 %[d], %[s0], %[k01], 0 " MIXL "\n\t"
                            "v_fma_mix_f32 %[yo], %[s0], %[r01], 0 " MIXL "\n\t"
                            "v_fma_mix_f32 %[d], %[s1], %[k01], %[d] " MIXH "\n\t"
                            "v_fma_mix_f32 %[yo], %[s1], %[r01], %[yo] " MIXH "\n\t"
                            "v_fma_mix_f32 %[d], %[s2], %[k23], %[d] " MIXL "\n\t"
                            "v_fma_mix_f32 %[yo], %[s2], %[r23], %[yo] " MIXL "\n\t"
                            "v_fma_mix_f32 %[d], %[s3], %[k23], %[d] " MIXH "\n\t"
                            "v_fma_mix_f32 %[yo], %[s3], %[r23], %[yo] " MIXH "\n\t"
                            "v_fma_mix_f32 v244, %[c01], %[v], 0 " MIXL0 "\n\t"
                            "v_fma_mix_f32 v245, %[c01], %[v], 0 " MIXH0 "\n\t"
                            "v_add_f32_dpp %[d], %[d], %[d] quad_perm:[1,0,3,2] row_mask:0xf bank_mask:0xf bound_ctrl:1\n\t"
                            "v_fma_mix_f32 v246, %[c23], %[v], 0 " MIXL0 "\n\t"
                            "v_fma_mix_f32 v247, %[c23], %[v], 0 " MIXH0 "\n\t"
                            "v_add_f32_dpp %[d], %[d], %[d] quad_perm:[2,3,0,1] row_mask:0xf bank_mask:0xf bound_ctrl:1\n\t"
                            "v_fmac_f32 v244, %[s0], %[w0]\n\t"
                            "v_fmac_f32 v245, %[s1], %[w1]\n\t"
                            "v_add_f32_dpp %[d], %[d], %[d] row_half_mirror row_mask:0xf bank_mask:0xf bound_ctrl:1\n\t"
                            "v_fmac_f32 v246, %[s2], %[w2]\n\t"
                            "v_fmac_f32 v247, %[s3], %[w3]\n\t"
                            "v_add_f32_dpp %[d], %[d], %[d] row_mirror row_mask:0xf bank_mask:0xf bound_ctrl:1\n\t"
                            "v_fma_mix_f32 %[s0], %[b01], %[d], v244 " MIXL0 "\n\t"
                            "v_fma_mix_f32 %[s1], %[b01], %[d], v245 " MIXH0 "\n\t"
                            "v_fma_mix_f32 %[s2], %[b23], %[d], v246 " MIXL0 "\n\t"
                            "v_fma_mix_f32 %[s3], %[b23], %[d], v247 " MIXH0
                            : [s0] "+v"(s0), [s1] "+v"(s1), [s2] "+v"(s2), [s3] "+v"(s3), [d] "=&v"(dd), [yo] "=&v"(yo)
                            : [k01] "v"(cur.kk[0]), [k23] "v"(cur.kk[1]), [r01] "v"(rp[0]), [r23] "v"(rp[1]), [c01] "v"(cur.kd[0]), [c23] "v"(cur.kd[1]),
                              [w0] "v"(cur.w[0]), [w1] "v"(cur.w[1]), [w2] "v"(cur.w[2]), [w3] "v"(cur.w[3]), [b01] "v"(cur.bb[0]), [b23] "v"(cur.bb[1]), [v] "v"(vf)
                            : "v244", "v245", "v246", "v247");
                        S01 = (f32x2){s0, s1}; S23 = (f32x2){s2, s3};
                        if (t > 0) { if (t & 1) ye = yo; else *(LAS unsigned*)(ypb + ((t - 2) >> 1) * 1024) = cvt_pk_bf16(ye, yo); }
                    }
#undef MIXL
#undef MIXH
#undef MIXL0
#undef MIXH0
                    rp = cur.r;
                    cur = nxt; nxt = nn; if (((t + 1) & 3) == 0) vq = vqn;
                    SB_();
                }
                { const h16x4 hr = __builtin_bit_cast(h16x4, rp); const float yl = (S01[0] * (float)hr[0] + S01[1] * (float)hr[1]) + (S23[0] * (float)hr[2] + S23[1] * (float)hr[3]);
                  *(LAS unsigned*)(ypb + 15 * 1024) = cvt_pk_bf16(ye, yl); }
#undef SB_
                SCN_BAR();
            }
            __builtin_amdgcn_s_setprio(0);
        }
    }
}
DI void phase_rwkv_out(const Ctx& P, int lane, int gw, int NGW) {
    unsigned char* ws = P.ws;
    const bf16_t* YS = (const bf16_t*)(ws + WS_YS); const h16* Vm = (const h16*)(ws + WS_RKV16) + 2 * ROWB; const bf16_t* Gm = (const bf16_t*)(ws + WS_G); const float* BONUS = (const float*)(ws + WS_BONUS2);
    bf16_t* HA0 = (bf16_t*)(ws + WS_HA0);
    const int c0 = 16 * lane, head = lane >> 2;
    const float* lnw = P.in(I_BLNW) + c0; const float* lnb = P.in(I_BLNB) + c0;
    for (int row = gw; row < MROWS; row += NGW) {
        float y[16], v[16];
#pragma unroll
        for (int q = 0; q < 2; ++q) { const u32x4 a = ((const u32x4*)(YS + (size_t)row * DM + c0))[q], b = ((const u32x4*)(YS + ROWB + (size_t)row * DM + c0))[q];
#pragma unroll
            for (int z = 0; z < 4; ++z) { y[8 * q + 2 * z] = bf_lo(a[z]) + bf_lo(b[z]); y[8 * q + 2 * z + 1] = bf_hi(a[z]) + bf_hi(b[z]); } }
        float s = 0.f;
#pragma unroll
        for (int i = 0; i < 16; ++i) s += y[i];
        s += __shfl_xor(s, 1); s += __shfl_xor(s, 2);
        const float mean = s * (1.0f / 64.0f);
        float q2 = 0.f;
#pragma unroll
        for (int i = 0; i < 16; ++i) { y[i] -= mean; q2 += y[i] * y[i]; }
        q2 += __shfl_xor(q2, 1); q2 += __shfl_xor(q2, 2);
        const float rstd = rsqrtf(q2 * (1.0f / 64.0f) + LN_X_EPS);
        ld16h(Vm + (size_t)row * DM + c0, v);
        const float bon = BONUS[(size_t)row * 16 + head] + BONUS[((size_t)MROWS + row) * 16 + head];
        const u32x4 g0 = ((const u32x4*)(Gm + (size_t)row * DM + c0))[0], g1 = ((const u32x4*)(Gm + (size_t)row * DM + c0))[1];
        float g[16];
        g[0] = bf_lo(g0.x); g[1] = bf_hi(g0.x); g[2] = bf_lo(g0.y); g[3] = bf_hi(g0.y); g[4] = bf_lo(g0.z); g[5] = bf_hi(g0.z); g[6] = bf_lo(g0.w); g[7] = bf_hi(g0.w);
        g[8] = bf_lo(g1.x); g[9] = bf_hi(g1.x); g[10] = bf_lo(g1.y); g[11] = bf_hi(g1.y); g[12] = bf_lo(g1.z); g[13] = bf_hi(g1.z); g[14] = bf_lo(g1.w); g[15] = bf_hi(g1.w);
        float o[16];
#pragma unroll
        for (int i = 0; i < 16; ++i) o[i] = (y[i] * rstd * lnw[i] + lnb[i] + bon * v[i]) * g[i];
        u32x4 w0, w1;
        w0.x = cvt_pk_bf16(o[0], o[1]); w0.y = cvt_pk_bf16(o[2], o[3]); w0.z = cvt_pk_bf16(o[4], o[5]); w0.w = cvt_pk_bf16(o[6], o[7]);
        w1.x = cvt_pk_bf16(o[8], o[9]); w1.y = cvt_pk_bf16(o[10], o[11]); w1.z = cvt_pk_bf16(o[12], o[13]); w1.w = cvt_pk_bf16(o[14], o[15]);
        ((u32x4*)(HA0 + (size_t)row * DM + c0))[0] = w0; ((u32x4*)(HA0 + (size_t)row * DM + c0))[1] = w1;
    }
}

#define FRESH() do { tid = threadIdx.x; asm volatile("" : "+v"(tid)); lane = tid & 63; wave = __builtin_amdgcn_readfirstlane(tid >> 6); gw = bx * 8 + wave; } while (0)
#define GRID_BAR() do { xcd_barrier_fn(bar.bar, bar.x, bar.st, tid); FRESH(); } while (0)
template <int L> DI void run_layer(const Ctx& P, LAS unsigned char* lds, const XcdBarrier& bar) {
    int tid, lane, wave, gw;
    const int G = gridDim.x, bx = blockIdx.x, NGW = G * 8;
    unsigned char* ws = P.ws;
    FRESH();

        constexpr int l = L; constexpr int kind = L % 3, j = L / 3; constexpr bool last = (L == DEPTH - 1);
        phase_norm1(P, l, kind == 1, lds, tid, lane, gw, NGW);
        GRID_BAR();
        if (kind != 1) {
            {
                const bool dense = kind == 0;
                SchedDense S; S.A = (const char*)(ws + WS_HA0); S.B = dense ? (const char*)(ws + WS_WAQKV) + (size_t)j * 1536 * 1024 * 2 : (const char*)(ws + WS_WCQKV);
                S.nN = dense ? 6 : 5; S.nM = 66; S.G = G; S.c = bx; S.pm0 = 0; S.tileb = (size_t)256 * 1024 * 2;
                EpiQKV E; E.Q = (bf16_t*)(ws + WS_Q); E.K = (bf16_t*)(ws + WS_K); E.V = (bf16_t*)(ws + WS_V); E.dense = dense ? 1 : 0;
                E.qgain = P.in(I_AQG) + j * 64; E.kgain = P.in(I_AKG) + j * 64; E.RT = (const float*)(ws + WS_ROPE); E.xch = (LAS float*)(lds + 135168);
                pg8::gemm_phase(lds, 1024, S, E, tid);
            }
            GRID_BAR();
            phase_attention(P, kind == 0, j, !last, lds, tid, lane, wave);
            GRID_BAR();
        } else {
            {   SchedRkvl S; S.MIX = (const char*)(ws + WS_MIX); S.B = (const char*)(ws + WS_WBRKVL); S.G = G; S.c = bx;
                EpiRkvl E; E.RKV = (h16*)(ws + WS_RKV16); E.TWA = (bf16_t*)(ws + WS_TWA); E.TG = (bf16_t*)(ws + WS_TG);
                pg8::gemm_phase(lds, 1024, S, E, tid);
            }
            GRID_BAR();
            {   SchedLora2 S; S.TWA = (const char*)(ws + WS_TWA); S.TG = (const char*)(ws + WS_TG); S.B = (const char*)(ws + WS_WBL2); S.G = G; S.c = bx;
                EpiLora2 E; E.EA = (h16*)(ws + WS_EA16); E.Gm = (bf16_t*)(ws + WS_G); E.w0 = P.in(I_BW0); E.a0 = P.in(I_BA0);
                int k128 = 128; asm volatile("" : "+s"(k128));
                pg8::gemm_phase(lds, k128, S, E, tid, 256);
            }
            GRID_BAR();
            phase_rwkv_scan(P, lds, tid, lane, wave);
            GRID_BAR();
            phase_rwkv_out(P, lane, gw, NGW);
            GRID_BAR();
        }
        {
            SchedDense S; S.A = kind == 1 ? (const char*)(ws + WS_HA0) : (const char*)(ws + WS_O);
            S.B = kind == 0 ? (const char*)(ws + WS_WAO) + (size_t)j * 1024 * 1024 * 2 : kind == 1 ? (const char*)(ws + WS_WBO) : (const char*)(ws + WS_WCO);
            S.nN = 4; S.pm0 = 2; S.nM = 64; S.G = G; S.c = bx; S.tileb = (size_t)256 * 1024 * 2;
            EpiResid E; E.X = (bf16_t*)(ws + xres_of(l)); E.gate_l = (const float*)(ws + WS_MOD) + (size_t)l * 3 * 6 * 1024 + 2 * 1024; E.scale = 1.0f;
            pg8::gemm_phase(lds, 1024, S, E, tid);
            if (!last) {
                SchedCtxSplit S2; S2.A = S.A; S2.B = S.B; S2.c = bx;
                EpiPartial E2; E2.PART = (float*)(ws + WS_PART);
                int k128 = 128; asm volatile("" : "+s"(k128));
                pg8::gemm_phase(lds, k128, S2, E2, tid, 1024);
            }
        }
        GRID_BAR();
        phase_norm2_router(P, l, lds, tid, lane, gw, NGW);
        GRID_BAR();
        {
        {   const int nblk = moe_tables(P, l, lds, tid);
            SchedMoeG S; S.A = (const char*)(ws + WS_HA0); S.B = (const char*)(ws + WS_WM13) + (size_t)l * 32 * 1536 * 1024 * 2; S.nM = nblk; S.G = G; S.c = bx;
            S.blk_e = (const LAS int*)(lds + LDS_MISC + MISC_BLKE); S.ltok = (const LAS int*)(lds + LDS_LTOK); S.start = (const LAS int*)(lds + LDS_MISC + MISC_START); S.cnt = (const LAS int*)(lds + LDS_MISC + MISC_CNTL);
            {
                const int* LIST = (const int*)(ws + WS_LIST); LAS int* lt_ = (LAS int*)(lds + LDS_LTOK); Unit u;
                const LAS int* start = (const LAS int*)(lds + LDS_MISC + MISC_START); const LAS int* cnt_l = (const LAS int*)(lds + LDS_MISC + MISC_CNTL);
                for (int i = 0; i < 4; ++i) { if (!S.next(i, u)) break;
                    if (tid < 256) { const int e = S.blk_e[u.pm], pos = u.pm * 256 - start[e] + tid; lt_[i * 256 + tid] = pos < cnt_l[e] ? LIST[(size_t)e * MROWS + pos] : 0; } }
                __syncthreads();
            }
            EpiMoe1 E; E.H = (bf16_t*)(ws + WS_HID);
            pg8::gemm_phase(lds, 1024, S, E, tid);
        }
        GRID_BAR();
        {   const int nblk = ((const LAS int*)(lds + LDS_MISC + MISC_START))[NEXP] >> 8;
            SchedMoe S; S.A = (const char*)(ws + WS_HID); S.B = (const char*)(ws + WS_WM2) + (size_t)l * 32 * 1024 * 768 * 2; S.nN = 4; S.nM = nblk; S.G = G; S.c = bx;
            S.atile = (size_t)256 * 768 * 2; S.btile = (size_t)256 * 768 * 2; S.bexp = (size_t)1024 * 768 * 2; S.blk_e = (const LAS int*)(lds + LDS_MISC + MISC_BLKE); S.start = (const LAS int*)(lds + LDS_MISC + MISC_START); S.cnt = (const LAS int*)(lds + LDS_MISC + MISC_CNTL);
            EpiMoe2 E; E.Y = (bf16_t*)(ws + WS_YASG);
            pg8::gemm_phase(lds, 768, S, E, tid);
        }
        GRID_BAR();
        }
    }
__global__ void __launch_bounds__(512, 2) hybrid_fwd(Params KP) {
    extern __shared__ __attribute__((aligned(16))) unsigned char lds_raw[];
    LAS unsigned char* lds = (LAS unsigned char*)lds_raw;
    int tid, lane, wave, gw;
    const int G = gridDim.x, bx = blockIdx.x, NGW = G * 8;
    FRESH();
    unsigned char* ws = KP.ws;
    for (int i = tid; i < (LDS_BYTES - LDS_MISC) / 4; i += 512) ((LAS unsigned*)(lds + LDS_MISC))[i] = 0u;
    __syncthreads();
    if (tid < N_IN) ((LAS unsigned long long*)(lds + LDS_MISC + MISC_PTAB))[tid] = (unsigned long long)KP.in[tid];
    __syncthreads();
    Ctx P; P.tab = (const volatile LAS unsigned long long*)(lds + LDS_MISC + MISC_PTAB); P.ws = ws; P.out = KP.out;
    const XcdBarrier bar = xcd_barrier_post((unsigned*)(ws + WS_CTL) + CW_BAR, (volatile LAS unsigned*)(lds + LDS_MISC + MISC_BAR));

    phase_prologue(P, lds, tid, lane, wave);
    GRID_BAR();

    run_layer<0>(P, lds, bar); run_layer<1>(P, lds, bar); run_layer<2>(P, lds, bar); run_layer<3>(P, lds, bar);
    FRESH();
    phase_final(P, lds, tid, lane, gw, NGW);
}

extern "C" void kernel_launch(void* const* d_in, const int* in_sizes, int n_in, void* d_out, int out_size, void* d_ws, size_t ws_size, hipStream_t stream) {
    static int grid = 0;
    if (grid == 0) {
        if (n_in != N_IN || out_size != NB * SEQ * DM || ws_size < WS_END) { fprintf(stderr, "kernel_launch: unexpected problem (n_in %d, out %d, ws %zu < %zu); nothing launched\n", n_in, out_size, ws_size, (size_t)WS_END); grid = -1; return; }
        int dev = 0, cus = 0, per_cu = 0;
        if (hipGetDevice(&dev) != hipSuccess || hipDeviceGetAttribute(&cus, hipDeviceAttributeMultiprocessorCount, dev) != hipSuccess) { grid = -1; return; }
        if (hipFuncSetAttribute((const void*)hybrid_fwd, hipFuncAttributeMaxDynamicSharedMemorySize, LDS_BYTES) != hipSuccess) { fprintf(stderr, "kernel_launch: hipFuncSetAttribute failed\n"); grid = -1; return; }
        if (hipOccupancyMaxActiveBlocksPerMultiprocessor(&per_cu, (const void*)hybrid_fwd, 512, LDS_BYTES) != hipSuccess || per_cu < 1) { fprintf(stderr, "kernel_launch: occupancy query says %d\n", per_cu); }
        (void)hipGetLastError();
        grid = cus;
    }
    if (grid < 0) return;
    (void)in_sizes;
    if (hipMemsetAsync((char*)d_ws + WS_CTL, 0, CTL_ZERO_BYTES, stream) != hipSuccess) { fprintf(stderr, "kernel_launch: memset failed\n"); return; }
    Params p{};
    for (int i = 0; i < N_IN; ++i) p.in[i] = (const float*)d_in[i];
    p.out = (float*)d_out; p.ws = (unsigned char*)d_ws;
    hipLaunchKernelGGL(hybrid_fwd, dim3(grid), dim3(512), LDS_BYTES, stream, p);
    const hipError_t le = hipPeekAtLastError();
    if (le != hipSuccess) fprintf(stderr, "kernel_launch: launch failed: %s\n", hipGetErrorName(le));
}
```

```cpp
#include <hip/hip_runtime.h>
#include <cstdio>
#include <cstdint>

#define DI __device__ __forceinline__
#define LAS __attribute__((address_space(3)))
typedef unsigned short bf16_t;
typedef short bf16x8 __attribute__((ext_vector_type(8)));
typedef short s16x4 __attribute__((ext_vector_type(4)));
typedef float f32x2 __attribute__((ext_vector_type(2)));
typedef float f32x4 __attribute__((ext_vector_type(4)));
typedef float f32x16 __attribute__((ext_vector_type(16)));
typedef unsigned u32x2 __attribute__((ext_vector_type(2)));
typedef unsigned u32x4 __attribute__((ext_vector_type(4)));
typedef _Float16 h16;
typedef _Float16 h16x8 __attribute__((ext_vector_type(8)));
typedef _Float16 h16x4 __attribute__((ext_vector_type(4)));
typedef __bf16 bf16x2_t __attribute__((ext_vector_type(2)));

constexpr int DM = 1024, NB = 2, SEQ = 8192, NCTX = 256, NCTXR = NB * NCTX, MROWS = NCTXR + NB * SEQ, KVLEN = NCTX + SEQ;
constexpr int NEXP = 32, DEXP = 768, MOE_MAXBLK = 164, MOE_ROWS = MOE_MAXBLK * 256;
constexpr int DEPTH = 4;
constexpr float NORM_EPS = 1e-6f, LN_X_EPS = 64e-5f;
constexpr float C2 = 0.125f * 1.4426950408889634f;
constexpr float LOG2E = 1.4426950408889634f;

enum { I_X = 0, I_C, I_CTX, I_CCTX, I_MODW, I_MODB, I_N1G, I_N2G, I_AQKV, I_AO, I_AQG, I_AKG, I_BMU, I_BWR, I_BWK, I_BWV, I_BWO, I_BW0, I_BW1, I_BW2,
       I_BA0, I_BA1, I_BA2, I_BG1, I_BG2, I_BKK, I_BKA, I_BRK, I_BLNW, I_BLNB, I_CQKV, I_CO, I_CSINK, I_MWG, I_MBG, I_MWE, I_MBE, I_MW1, I_MW3, I_MW2, I_FG, N_IN };

constexpr size_t MiB = 1ull << 20;
constexpr size_t WS_CTL = 0, CTL_ZERO_BYTES = 1 * MiB;
constexpr size_t WS_MOD = 1 * MiB;
constexpr size_t WS_ROPE = WS_MOD + 512 * 1024;
constexpr size_t WS_WR = 2 * MiB;
constexpr size_t WS_TOK = 3 * MiB;
constexpr size_t TOK_STRIDE = (size_t)MROWS * 8;
constexpr size_t WS_ROWTOK = WS_TOK + 4 * TOK_STRIDE;
constexpr size_t WS_BONUS = 4 * MiB;
constexpr size_t WS_WAQKV = 6 * MiB;
constexpr size_t WS_WAO = 12 * MiB;
constexpr size_t WS_WCQKV = 16 * MiB;
constexpr size_t WS_WCO = 19 * MiB;
constexpr size_t WS_WBRKVL = 21 * MiB;
constexpr size_t WS_WBO = 29 * MiB;
constexpr size_t WS_WBL2 = 31 * MiB;
constexpr size_t WS_WM13 = 34 * MiB;
constexpr size_t WS_WM2 = 418 * MiB;
constexpr size_t WS_XRES = 610 * MiB;
constexpr size_t WS_HA0 = 676 * MiB;
constexpr size_t WS_A = 709 * MiB;
constexpr size_t WS_B = 907 * MiB;
constexpr size_t WS_C = 1023 * MiB;
constexpr size_t WS_XRES2 = 1353 * MiB;
constexpr size_t WS_PART = 1419 * MiB;
constexpr size_t WS_BONUS2 = 1435 * MiB;
constexpr size_t WS_LIST = 1438 * MiB;
constexpr size_t WS_END = 1441 * MiB;
constexpr size_t ROWB = (size_t)MROWS * DM;
constexpr size_t WS_MIX = WS_A;
constexpr size_t WS_EA16 = WS_A;
constexpr size_t WS_G = WS_A + 132 * MiB;
constexpr size_t WS_YS = WS_C;
constexpr size_t WS_Q = WS_A;
constexpr size_t WS_O = WS_A + 33 * MiB;
constexpr size_t WS_K = WS_A + 66 * MiB;
constexpr size_t WS_V = WS_A + 75 * MiB;
constexpr size_t WS_RKV16 = WS_B;
constexpr size_t WS_TWA = WS_B + 99 * MiB;
constexpr size_t WS_TG = WS_B + 99 * MiB + (size_t)MROWS * 256 * 2;
constexpr size_t WS_SC = WS_C;
constexpr size_t WS_ASORT = WS_C;
constexpr size_t WS_HID = WS_C + 82 * MiB;
constexpr size_t WS_YASG = WS_C + 144 * MiB;
static_assert(WS_TG + (size_t)MROWS * 256 * 2 <= WS_C && WS_YASG + (size_t)MOE_ROWS * 1024 * 2 <= WS_END && (size_t)64 * KVLEN * 640 <= 330 * MiB, "ws map");
static_assert(WS_WM13 + (size_t)128 * 1536 * 1024 * 2 <= WS_WM2 && WS_WM2 + (size_t)128 * 1024 * 768 * 2 <= WS_XRES, "ws map 2");
constexpr int CW_BAR = 4096;
constexpr int CW_CNT = 16384, CNT_STRIDE = 32;

constexpr int LDS_MISC = 147456;
constexpr int LDS_BYTES = LDS_MISC + 4096;
constexpr int MISC_BAR = 0, MISC_START = 64, MISC_BLKE = 256, MISC_PTAB = 1024, MISC_CNTL = 1536;

DI size_t xres_of(int l) { return l == 1 ? WS_XRES2 : WS_XRES; }
struct Params { const float* in[N_IN]; float* out; unsigned char* ws; };
struct Ctx { const volatile LAS unsigned long long* tab; unsigned char* ws; float* out;
    __device__ __forceinline__ const float* in(int i) const { const unsigned long long v = tab[i];
        const unsigned lo = __builtin_amdgcn_readfirstlane((unsigned)v), hi = __builtin_amdgcn_readfirstlane((unsigned)(v >> 32));
        return (const float*)(const __attribute__((address_space(1))) float*)(((unsigned long long)hi << 32) | lo); } };

DI unsigned cvt_pk_bf16(float lo, float hi) { f32x2 v = {lo, hi}; bf16x2_t b = __builtin_convertvector(v, bf16x2_t); return __builtin_bit_cast(unsigned, b); }
DI float bf_lo(unsigned u) { return __builtin_bit_cast(float, u << 16); }
DI float bf_hi(unsigned u) { return __builtin_bit_cast(float, u & 0xffff0000u); }
DI float wave_sum(float v) {
#pragma unroll
    for (int o = 1; o < 64; o <<= 1) v += __shfl_xor(v, o);
    return v;
}
template <int CTRL> DI float dpp_add(float x) { const int xi = __builtin_bit_cast(int, x); const int yi = __builtin_amdgcn_update_dpp(0, xi, CTRL, 0xF, 0xF, true); return x + __builtin_bit_cast(float, yi); }
DI float allreduce16(float x) { x = dpp_add<0xB1>(x); x = dpp_add<0x4E>(x); x = dpp_add<0x141>(x); x = dpp_add<0x140>(x); return x; }
template <int CTRL> DI float dpp_mov(float x) { return __builtin_bit_cast(float, __builtin_amdgcn_update_dpp(0, __builtin_bit_cast(int, x), CTRL, 0xF, 0xF, true)); }
DI float merge4_reduce16(float a, float b, float c, float d, int lane) {
    const bool b0 = (lane & 1) != 0, b1 = (lane & 2) != 0;
    const float x = (b0 ? b : a) + dpp_mov<0xB1>(b0 ? a : b);
    const float z = (b0 ? d : c) + dpp_mov<0xB1>(b0 ? c : d);
    float w = (b1 ? z : x) + dpp_mov<0x4E>(b1 ? x : z);
    w += dpp_mov<0x124>(w); w += dpp_mov<0x128>(w);
    return w;
}
DI float wave_sum_dpp(float x) { x = allreduce16(x);
    const float a = __builtin_bit_cast(float, __builtin_amdgcn_readlane(__builtin_bit_cast(int, x), 0)), b = __builtin_bit_cast(float, __builtin_amdgcn_readlane(__builtin_bit_cast(int, x), 16)),
                c = __builtin_bit_cast(float, __builtin_amdgcn_readlane(__builtin_bit_cast(int, x), 32)), d = __builtin_bit_cast(float, __builtin_amdgcn_readlane(__builtin_bit_cast(int, x), 48));
    return (a + b) + (c + d); }
DI int vec_of_row(int row) { return row < NCTXR ? 2 : ((row - NCTXR) >> 13); }
DI int kvrow_of(int row) { if (row < NCTXR) return (row >> 8) * KVLEN + (row & 255); const int r = row - NCTXR; return (r >> 13) * KVLEN + NCTX + (r & 8191); }
DI float silu_f(float x) { return x * __builtin_amdgcn_rcpf(1.f + __expf(-x)); }
DI float sigmoid_f(float x) { return __builtin_amdgcn_rcpf(1.f + __expf(-x)); }

#define XB_TMO      128
#define XB_XCNT(j)  (256  + 64 * (j))
#define XB_XSUB(j)  (1280 + 64 * (j))
#define XB_XGEN(j)  (2304 + 64 * (j))
#define XB_TOP      3328
#define XB_TOPGEN   3392
#define XCD_BAR_WORDS 3456
#define XB_SPIN_CAP (1u << 20)
DI unsigned xb_ld(unsigned* p)              { return __hip_atomic_load(p, __ATOMIC_RELAXED, __HIP_MEMORY_SCOPE_AGENT); }
DI unsigned xb_add(unsigned* p, unsigned v) { return __hip_atomic_fetch_add(p, v, __ATOMIC_RELAXED, __HIP_MEMORY_SCOPE_AGENT); }
DI unsigned xb_xcc_id() { return (unsigned)__builtin_amdgcn_s_getreg((3 << 11) | 20) & 0xFu; }
#define XB_SPIN(cond, bar) do { unsigned _sp = 0; while (cond) { __builtin_amdgcn_s_sleep(1); \
    if ((++_sp & 255u) == 0u) { if (xb_ld(&(bar)[XB_TMO])) break; if (_sp > XB_SPIN_CAP) { atomicAdd(&(bar)[XB_TMO], 1u); break; } } } } while (0)
struct XcdBarrier { unsigned* bar; unsigned x; volatile LAS unsigned* st; };
DI XcdBarrier xcd_barrier_post(unsigned* bar, volatile LAS unsigned* st) {
    XcdBarrier b; b.bar = bar; b.x = xb_xcc_id(); b.st = st;
    if (threadIdx.x == 0) (void)xb_add(&bar[XB_XCNT(b.x)], 1u);
    return b;
}
DI void xcd_barrier_complete(unsigned* bar, unsigned x, unsigned& nloc, unsigned& nx) {
    const unsigned G = gridDim.x * gridDim.y * gridDim.z;
    unsigned sum, cnt, mine, sp = 0u;
    for (;;) {
        sum = 0u; cnt = 0u; mine = 0u;
#pragma unroll
        for (unsigned j = 0; j < 16; ++j) { const unsigned c = xb_ld(&bar[XB_XCNT(j)]); sum += c; cnt += (c > 0u) ? 1u : 0u; mine = (j == x) ? c : mine; }
        if (sum == G) break;
        __builtin_amdgcn_s_sleep(1);
        if ((++sp & 255u) == 0u) { if (xb_ld(&bar[XB_TMO])) break; if (sp > XB_SPIN_CAP) { atomicAdd(&bar[XB_TMO], 1u); break; } }
    }
    nloc = mine > 0u ? mine : 1u; nx = cnt > 0u ? cnt : 1u;
}
__device__ __attribute__((noinline)) void xcd_barrier_fn(unsigned* bar_, unsigned x_, volatile LAS unsigned* st_, int tid_) {
    XcdBarrier b; b.bar = bar_; b.x = x_; b.st = st_;
    asm volatile("s_waitcnt vmcnt(0)" ::: "memory");
    __syncthreads();
    if (tid_ == 0) {
        unsigned* bar = b.bar;
        __builtin_amdgcn_s_waitcnt(0);
        unsigned nloc = b.st[0], nx = b.st[1];
        if (nloc == 0u) { xcd_barrier_complete(bar, b.x, nloc, nx); b.st[0] = nloc; b.st[1] = nx; }
        asm volatile("buffer_inv sc1" ::: "memory");
        const unsigned old = xb_add(&bar[XB_XSUB(b.x)], 1u);
        const unsigned gen = old / nloc;
        if (old + 1u == (gen + 1u) * nloc) {
            __builtin_amdgcn_fence(__ATOMIC_RELEASE, "agent");
            asm volatile("s_waitcnt vmcnt(0)" ::: "memory");
            const unsigned og = xb_add(&bar[XB_TOP], 1u);
            const unsigned tg = og / nx;
            if (og + 1u == (tg + 1u) * nx) xb_add(&bar[XB_TOPGEN], 1u);
            else XB_SPIN(xb_ld(&bar[XB_TOPGEN]) == tg, bar);
            xb_add(&bar[XB_XGEN(b.x)], 1u);
            asm volatile("s_waitcnt vmcnt(0)" ::: "memory");
        } else {
            XB_SPIN(xb_ld(&bar[XB_XGEN(b.x)]) == gen, bar);
            asm volatile("s_waitcnt vmcnt(0)" ::: "memory");
        }
    }
    __syncthreads();
}

namespace pg8 {
constexpr int BM = 256, BK = 64, HALF = 128, HTB = HALF * BK * 2;
DI int lds_byte(int r, int c) { const int st = (r >> 4) * 2 + (c >> 5), rr = r & 15, cc = c & 31, ob = rr * 64 + cc * 2; return st * 1024 + (ob ^ (((ob >> 9) & 1) << 5)); }
DI void stage_rc(int b, int& R, int& C) { const int st = b / 1024, sb = b % 1024, swz = sb ^ (((sb >> 9) & 1) << 5); R = (st >> 1) * 16 + swz / 64; C = (st & 1) * 32 + (swz % 64) / 2; }
DI int perm32(int rho) { const int n = rho >> 4, i = rho & 15; return 8 * (i >> 2) + 4 * n + (i & 3); }
struct Unit { int pm, pn; const char* A; const char* B; int tok; int half; };

template <class Epi, class Sched>
DI void gemm_phase(LAS unsigned char* lds, const int K, const Sched& S, const Epi& E, const int tid, const int ld_ = 0) {
    const int ld = ld_ ? ld_ : K;
    const int wid = __builtin_amdgcn_readfirstlane(tid >> 6), lane = tid & 63, wr = wid >> 2, wc = wid & 3, fr = lane & 15, fq = lane >> 4;
    const int nt = K / BK;
    unsigned voffA[2], voffB[2];
#pragma unroll
    for (int i = 0; i < 2; ++i) { int R, C; stage_rc(tid * 16 + i * 8192, R, C); const int Rb = Epi::PERM ? ((R & ~31) + perm32(R & 31)) : R;
        voffA[i] = (unsigned)(R * ld + C) * 2u; voffB[i] = (unsigned)(Rb * ld + C) * 2u; }
    constexpr bool GA = Sched::GATHER;
    unsigned oA[2][2], nO[2][2]; int gR[2], gC2[2];
#pragma unroll
    for (int i = 0; i < 2; ++i) { int R, C; stage_rc(tid * 16 + i * 8192, R, C); gR[i] = R; gC2[i] = C * 2; oA[0][i] = oA[1][i] = nO[0][i] = nO[1][i] = 0u; }
#define PG8_TOKOFF(dst, u) do { _Pragma("unroll") for (int _h = 0; _h < 2; ++_h) _Pragma("unroll") for (int _i = 0; _i < 2; ++_i) dst[_h][_i] = (unsigned)S.tokrow((u).tok + _h * 128 + gR[_i]) * (unsigned)(ld * 2) + (unsigned)gC2[_i]; } while (0)
    const size_t kstep = (size_t)(BK * 2);
    const size_t hstep = (size_t)HALF * ld * 2;
    const unsigned ldsw = (unsigned)wid * 1024u;
    const int aoff = lds_byte(wr * 64 + fr, fq * 8), boff = lds_byte(wc * 32 + fr, fq * 8);
#define PG8_SA(b, h) (((b) * 2 + (h)) * HTB)
#define PG8_SB(b, h) ((4 + (b) * 2 + (h)) * HTB)
#define PG8_STAGE(bufoff, gbase, voff) do { _Pragma("unroll") for (int _i = 0; _i < 2; ++_i) \
        __builtin_amdgcn_global_load_lds((const unsigned*)((const char*)(gbase) + (voff)[_i]), (LAS unsigned*)(lds + (bufoff) + ldsw + _i * 8192), 16, 0, 0); } while (0)
#define PG8_STAGE_A(bufoff, kptr, h, OFF) do { if constexpr (GA) PG8_STAGE(bufoff, kptr, OFF[h]); else PG8_STAGE(bufoff, (kptr) + (h) * hstep, voffA); } while (0)
#define PG8_LDA(dst, b, h) do { _Pragma("unroll") for (int m = 0; m < 4; ++m) _Pragma("unroll") for (int k = 0; k < 2; ++k) dst[m][k] = *(const LAS bf16x8*)(lds + PG8_SA(b, h) + aoff + m * 2048 + k * 1024); } while (0)
#define PG8_LDB(dst, b, h) do { _Pragma("unroll") for (int n = 0; n < 2; ++n) _Pragma("unroll") for (int k = 0; k < 2; ++k) dst[n][k] = *(const LAS bf16x8*)(lds + PG8_SB(b, h) + boff + n * 2048 + k * 1024); } while (0)
#define PG8_MMA(ai, bj, At, Bt) do { __builtin_amdgcn_s_setprio(1); _Pragma("unroll") for (int m = 0; m < 4; ++m) _Pragma("unroll") for (int n = 0; n < 2; ++n) _Pragma("unroll") for (int k = 0; k < 2; ++k) \
        acc[ai][bj][m][n] = __builtin_amdgcn_mfma_f32_16x16x32_bf16(Bt[n][k], At[m][k], acc[ai][bj][m][n], 0, 0, 0); __builtin_amdgcn_s_setprio(0); } while (0)
#define PG8_WAIT_V(n) asm volatile("s_waitcnt vmcnt(" #n ")" ::: "memory")
#define PG8_WAIT_L(n) asm volatile("s_waitcnt lgkmcnt(" #n ")" ::: "memory")
#define PG8_BAR __builtin_amdgcn_s_barrier()
#define PG8_SCHED __builtin_amdgcn_sched_barrier(0)
    Unit cur, nxt; int ui = 0;
    if (!S.next(0, cur)) return;
    bool halfu = false, skip0 = false; if constexpr (Sched::HALFTAIL) { const int vr_ = __builtin_amdgcn_readfirstlane(cur.half); skip0 = 64 * wr >= vr_; halfu = 128 + 64 * wr >= vr_; }
    f32x4 acc[2][2][4][2];
#pragma unroll
    for (int a = 0; a < 2; ++a)
#pragma unroll
        for (int b = 0; b < 2; ++b)
#pragma unroll
            for (int m = 0; m < 4; ++m)
#pragma unroll
                for (int n = 0; n < 2; ++n) acc[a][b][m][n] = (f32x4){0.f, 0.f, 0.f, 0.f};
    bf16x8 At[4][2], B0[2][2], B1[2][2];
    const char* cA = cur.A; const char* cB = cur.B;
    if constexpr (GA) { PG8_TOKOFF(oA, cur); }
    {
        PG8_STAGE(PG8_SB(0, 0), cB, voffB); PG8_STAGE(PG8_SB(0, 1), cB + hstep, voffB); PG8_STAGE_A(PG8_SA(0, 0), cA, 0, oA); PG8_STAGE_A(PG8_SA(0, 1), cA, 1, oA);
        if (wr == 1) PG8_BAR;
        PG8_WAIT_V(2); PG8_BAR;
        PG8_STAGE(PG8_SB(1, 0), cB + kstep, voffB); PG8_STAGE_A(PG8_SA(1, 0), cA + kstep, 0, oA); PG8_STAGE(PG8_SB(1, 1), cB + hstep + kstep, voffB);
        PG8_WAIT_V(6); PG8_BAR;
    }
    for (;;) {
        const bool has_next = S.next(ui + 1, nxt);
        const char* nA = has_next ? nxt.A : cA; const char* nB = has_next ? nxt.B : cB;
        if constexpr (GA) { if (has_next) { PG8_TOKOFF(nO, nxt); } else {
#pragma unroll
            for (int _h = 0; _h < 2; ++_h) { nO[_h][0] = oA[_h][0]; nO[_h][1] = oA[_h][1]; } } }
        for (int t = 0; t < nt; t += 2) {
            const bool last = (t == nt - 2);
            const char* a1 = cA + (size_t)(t + 1) * kstep;
            const char* a2 = last ? nA : cA + (size_t)(t + 2) * kstep; const char* b2 = last ? nB : cB + (size_t)(t + 2) * kstep;
            const char* a3 = a2 + kstep; const char* b3 = b2 + kstep;
            unsigned sO[2][2];
#pragma unroll
            for (int _h = 0; _h < 2; ++_h) { sO[_h][0] = last ? nO[_h][0] : oA[_h][0]; sO[_h][1] = last ? nO[_h][1] : oA[_h][1]; }
            if (!skip0) { PG8_LDB(B0, 0, 0); PG8_LDB(B1, 0, 1); PG8_SCHED; PG8_LDA(At, 0, 0); }
            PG8_STAGE_A(PG8_SA(1, 1), a1, 1, oA);
            PG8_WAIT_V(8); PG8_WAIT_L(0); PG8_BAR; if (!skip0) { PG8_MMA(0, 0, At, B0); PG8_MMA(0, 1, At, B1); } PG8_BAR; PG8_SCHED;
            if (!halfu) PG8_LDA(At, 0, 1);
            PG8_STAGE(PG8_SB(0, 0), b2, voffB); PG8_STAGE(PG8_SB(0, 1), b2 + hstep, voffB); PG8_STAGE_A(PG8_SA(0, 0), a2, 0, sO);
            PG8_WAIT_V(8); PG8_WAIT_L(0); PG8_BAR; if (!halfu) { PG8_MMA(1, 0, At, B0); PG8_MMA(1, 1, At, B1); } PG8_BAR; PG8_SCHED;
            if (!skip0) { PG8_LDB(B0, 1, 0); PG8_LDB(B1, 1, 1); PG8_SCHED; PG8_LDA(At, 1, 0); }
            PG8_STAGE_A(PG8_SA(0, 1), a2, 1, sO);
            PG8_WAIT_V(8); PG8_WAIT_L(0); PG8_BAR; if (!skip0) { PG8_MMA(0, 0, At, B0); PG8_MMA(0, 1, At, B1); } PG8_BAR; PG8_SCHED;
            if (!halfu) PG8_LDA(At, 1, 1);
            PG8_STAGE(PG8_SB(1, 0), b3, voffB); PG8_STAGE(PG8_SB(1, 1), b3 + hstep, voffB); PG8_STAGE_A(PG8_SA(1, 0), a3, 0, sO);
            PG8_WAIT_V(8); PG8_WAIT_L(0); PG8_BAR; if (!halfu) { PG8_MMA(1, 0, At, B0); PG8_MMA(1, 1, At, B1); } PG8_BAR; PG8_SCHED;
        }
        if (wr == 0) PG8_BAR;
        E(acc, cur, wr, wc, fr, fq);
        if (!has_next) break;
#pragma unroll
        for (int a = 0; a < 2; ++a)
#pragma unroll
            for (int b = 0; b < 2; ++b)
#pragma unroll
                for (int m = 0; m < 4; ++m)
#pragma unroll
                    for (int n = 0; n < 2; ++n) acc[a][b][m][n] = (f32x4){0.f, 0.f, 0.f, 0.f};
        cur = nxt; cA = nA; cB = nB; ++ui;
        if constexpr (Sched::HALFTAIL) { const int vr_ = __builtin_amdgcn_readfirstlane(cur.half); skip0 = 64 * wr >= vr_; halfu = 128 + 64 * wr >= vr_; }
        if constexpr (GA) {
#pragma unroll
            for (int _h = 0; _h < 2; ++_h) { oA[_h][0] = nO[_h][0]; oA[_h][1] = nO[_h][1]; } }
        if (wr == 1) PG8_BAR;
    }
    PG8_WAIT_V(0);
    PG8_BAR;
#undef PG8_SA
#undef PG8_SB
#undef PG8_STAGE
#undef PG8_STAGE_A
#undef PG8_TOKOFF
#undef PG8_LDA
#undef PG8_LDB
#undef PG8_MMA
#undef PG8_WAIT_V
#undef PG8_WAIT_L
#undef PG8_BAR
#undef PG8_SCHED
}
}
using pg8::Unit;

DI void tr_item(const float* __restrict__ W, int N, int k0, int n0, bf16_t* __restrict__ WT, int ldt, int drow0, int dk0, LAS float* scr, int lane) {
    float tv[32];
    const float* wp = W + (size_t)(k0 + (lane >> 5)) * N + n0 + (lane & 31);
#pragma unroll
    for (int i = 0; i < 32; ++i) tv[i] = __builtin_nontemporal_load(wp + (size_t)(2 * i) * N);
#pragma unroll
    for (int i = 0; i < 32; ++i) scr[(2 * i + (lane >> 5)) * 33 + (lane & 31)] = tv[i];
    asm volatile("s_waitcnt lgkmcnt(0)" ::: "memory");
    const int c = lane & 7;
#pragma unroll
    for (int j = 0; j < 4; ++j) { const int n = (lane >> 3) + 8 * j; const LAS float* s = scr + (8 * c) * 33 + n;
        u32x4 o; o.x = cvt_pk_bf16(s[0 * 33], s[1 * 33]); o.y = cvt_pk_bf16(s[2 * 33], s[3 * 33]); o.z = cvt_pk_bf16(s[4 * 33], s[5 * 33]); o.w = cvt_pk_bf16(s[6 * 33], s[7 * 33]);
        *(u32x4*)(WT + (size_t)(drow0 + n) * ldt + dk0 + k0 + 8 * c) = o; }
    asm volatile("s_waitcnt lgkmcnt(0)" ::: "memory");
}
#define TRJOB(W_, K_, N_, WT_, LDT_, DROW_EXPR, DK0_) { const int _ni = ((K_) / 64) * ((N_) / 32); if (it < _ni) { const int _nb = (N_) / 32; const int _kb = it / _nb, _n0 = 32 * (it % _nb); const int n0 = _n0; (void)n0; \
        tr_item((W_), (N_), 64 * _kb, _n0, (WT_), (LDT_), (DROW_EXPR), (DK0_), scr, lane); return; } it -= _ni; }

DI void prologue_small_item(const Ctx& P, int it, LAS float* scr, int lane) {
    unsigned char* ws = P.ws;
    bf16_t* WAQKV = (bf16_t*)(ws + WS_WAQKV); bf16_t* WAO = (bf16_t*)(ws + WS_WAO); bf16_t* WCQKV = (bf16_t*)(ws + WS_WCQKV); bf16_t* WCO = (bf16_t*)(ws + WS_WCO);
    bf16_t* WBR = (bf16_t*)(ws + WS_WBRKVL); bf16_t* WBO = (bf16_t*)(ws + WS_WBO); bf16_t* WBL2 = (bf16_t*)(ws + WS_WBL2);
    TRJOB(P.in(I_AQKV), 1024, 1536, WAQKV, 1024, n0, 0)
    TRJOB(P.in(I_AQKV) + 1024 * 1536, 1024, 1536, WAQKV + 1536 * 1024, 1024, n0, 0)
    TRJOB(P.in(I_AO), 1024, 1024, WAO, 1024, n0, 0)
    TRJOB(P.in(I_AO) + 1024 * 1024, 1024, 1024, WAO + 1024 * 1024, 1024, n0, 0)
    TRJOB(P.in(I_CQKV), 1024, 1280, WCQKV, 1024, n0, 0)
    TRJOB(P.in(I_CO), 1024, 1024, WCO, 1024, n0, 0)
    TRJOB(P.in(I_BWR), 1024, 1024, WBR, 1024, n0, 0)
    TRJOB(P.in(I_BWK), 1024, 1024, WBR, 1024, 1024 + n0, 0)
    TRJOB(P.in(I_BWV), 1024, 1024, WBR, 1024, 2048 + n0, 0)
    TRJOB(P.in(I_BWO), 1024, 1024, WBO, 1024, n0, 0)
    TRJOB(P.in(I_BW1), 1024, 64, WBR, 1024, 3072 + n0, 0)
    TRJOB(P.in(I_BW1) + 65536, 1024, 64, WBR, 1024, 3072 + 64 + n0, 0)
    TRJOB(P.in(I_BA1), 1024, 64, WBR, 1024, 3328 + n0, 0)
    TRJOB(P.in(I_BA1) + 65536, 1024, 64, WBR, 1024, 3328 + 64 + n0, 0)
    TRJOB(P.in(I_BG1), 1024, 128, WBR, 1024, 3584 + n0, 0)
    TRJOB(P.in(I_BW2), 64, 1024, WBL2, 256, n0, 0)
    TRJOB(P.in(I_BW2) + 65536, 64, 1024, WBL2, 256, 1024 + n0, 64)
    TRJOB(P.in(I_BA2), 64, 1024, WBL2, 256, 2048 + n0, 128)
    TRJOB(P.in(I_BA2) + 65536, 64, 1024, WBL2, 256, 3072 + n0, 192)
    TRJOB(P.in(I_BG2), 128, 1024, WBL2, 256, 4096 + n0, 0)
}
constexpr int N_SMALL_ITEMS = 2 * 768 + 2 * 512 + 640 + 512 + 4 * 512 + 4 * 32 + 64 + 4 * 32 + 64;
constexpr int N_MOE_ITEMS_PER = 3 * 384, N_MOE_ITEMS = 128 * N_MOE_ITEMS_PER, N_MOE_PRO = 32 * N_MOE_ITEMS_PER;
static_assert(N_MOE_ITEMS - N_MOE_PRO == 108 * 1024, "scan-side conversion: 1024 staging waves x 108 chunks");
DI void prologue_moe_item(const Ctx& P, int item, LAS float* scr, int lane) {
    const int le = item / N_MOE_ITEMS_PER; int it = item % N_MOE_ITEMS_PER;
    bf16_t* W13 = (bf16_t*)(P.ws + WS_WM13) + (size_t)le * 1536 * 1024; bf16_t* W2 = (bf16_t*)(P.ws + WS_WM2) + (size_t)le * 1024 * 768;
    TRJOB(P.in(I_MW1) + (size_t)le * 1024 * 768, 1024, 768, W13, 1024, (n0 >> 7) * 256 + (n0 & 127), 0)
    TRJOB(P.in(I_MW3) + (size_t)le * 1024 * 768, 1024, 768, W13, 1024, (n0 >> 7) * 256 + 128 + (n0 & 127), 0)
    TRJOB(P.in(I_MW2) + (size_t)le * 768 * 1024, 768, 1024, W2, 768, n0, 0)
}

struct MoeItem { const float* src; bf16_t* dst; int N; };
DI MoeItem moe_item_decode(const float* w1, const float* w3, const float* w2, unsigned char* ws, int item, int lane, int& ldt) {
    const int le = item / N_MOE_ITEMS_PER, it = item % N_MOE_ITEMS_PER, job = it / 384, idx = it % 384;
    MoeItem m;
    if (job < 2) { const int kb = idx / 24, n0 = 32 * (idx % 24); m.N = 768; ldt = 1024;
        m.src = (job == 0 ? w1 : w3) + (size_t)le * 1024 * 768 + (size_t)(64 * kb + (lane >> 5)) * 768 + n0 + (lane & 31);
        m.dst = (bf16_t*)(ws + WS_WM13) + (size_t)le * 1536 * 1024 + (size_t)((n0 >> 7) * 256 + (job == 1 ? 128 : 0) + (n0 & 127)) * 1024 + 64 * kb;
    } else { const int kb = idx / 32, n0 = 32 * (idx % 32); m.N = 1024; ldt = 768;
        m.src = w2 + (size_t)le * 768 * 1024 + (size_t)(64 * kb + (lane >> 5)) * 1024 + n0 + (lane & 31);
        m.dst = (bf16_t*)(ws + WS_WM2) + (size_t)le * 1024 * 768 + (size_t)n0 * 768 + 64 * kb; }
    return m;
}
DI void moe_item_load(const MoeItem& m, float (&tv)[32]) {
    const int N2 = 2 * m.N; const __attribute__((address_space(1))) float* sp = (const __attribute__((address_space(1))) float*)m.src;
#pragma unroll
    for (int i = 0; i < 32; ++i) tv[i] = __builtin_nontemporal_load(sp + (size_t)i * N2);
}
DI void moe_item_store(const MoeItem& m, int ldt, const float (&tv)[32], LAS float* scr, int lane) {
#pragma unroll
    for (int i = 0; i < 32; ++i) scr[(2 * i + (lane >> 5)) * 33 + (lane & 31)] = tv[i];
    asm volatile("s_waitcnt lgkmcnt(0)" ::: "memory");
    const int c = lane & 7;
#pragma unroll
    for (int j = 0; j < 4; ++j) { const int n = (lane >> 3) + 8 * j; const LAS float* sp = scr + (8 * c) * 33 + n;
        u32x4 o; o.x = cvt_pk_bf16(sp[0 * 33], sp[1 * 33]); o.y = cvt_pk_bf16(sp[2 * 33], sp[3 * 33]); o.z = cvt_pk_bf16(sp[4 * 33], sp[5 * 33]); o.w = cvt_pk_bf16(sp[6 * 33], sp[7 * 33]);
        *(u32x4*)(m.dst + (size_t)n * ldt + 8 * c) = o; }
    asm volatile("s_waitcnt lgkmcnt(0)" ::: "memory");
}
DI void phase_prologue(const Ctx& P, LAS unsigned char* lds, int tid, int lane, int wave) {
    const int G = gridDim.x, bx = blockIdx.x;
    unsigned char* ws = P.ws;
    LAS float* cond = (LAS float*)lds;
    LAS float* part = (LAS float*)(lds + 12288);
    { const float* cp = P.in(I_C); const float* ccp = P.in(I_CCTX);
      for (int i = tid; i < 3072; i += 512) { const int v = i >> 10, k = i & 1023; const float c = (v < 2) ? cp[v * 1024 + k] : ccp[k]; cond[i] = silu_f(c); } }
    __syncthreads();
    float* MOD = (float*)(ws + WS_MOD);
    const float* modw = P.in(I_MODW); const float* modb = P.in(I_MODB);
    for (int u = bx; u < 4 * 96; u += G) {
        const int l = u / 96, c0 = (u % 96) * 64;
        const float* W = modw + (size_t)l * 1024 * 6144 + c0 + lane;
        float a0 = 0.f, a1 = 0.f, a2 = 0.f;
        const int kb = wave * 128;
#pragma unroll 16
        for (int k = 0; k < 128; ++k) { const float w = W[(size_t)(kb + k) * 6144]; a0 += cond[kb + k] * w; a1 += cond[1024 + kb + k] * w; a2 += cond[2048 + kb + k] * w; }
        part[(wave * 3 + 0) * 64 + lane] = a0; part[(wave * 3 + 1) * 64 + lane] = a1; part[(wave * 3 + 2) * 64 + lane] = a2;
        __syncthreads();
        if (tid < 192) { const int v = tid >> 6, c = tid & 63; float s = 0.f;
#pragma unroll
            for (int w = 0; w < 8; ++w) s += part[(w * 3 + v) * 64 + c];
            const int j = c0 + c; MOD[((size_t)(l * 3 + v) * 6 + (j >> 10)) * 1024 + (j & 1023)] = s + modb[l * 6144 + j]; }
        __syncthreads();
    }
    const int gt = bx * 512 + tid, NGT = G * 512;
    {
        float* RT = (float*)(ws + WS_ROPE);
        for (int i = gt; i < 128 * 16; i += NGT) { const int p = i >> 4, f = i & 15; const float inv = powf(10000.0f, -(float)(2 * f) / 32.0f); const float ang = (float)p * inv; RT[2 * i] = cosf(ang); RT[2 * i + 1] = sinf(ang); }
        float* WR = (float*)(ws + WS_WR); const float* mwg = P.in(I_MWG); const float* mwe = P.in(I_MWE);
        for (int i = gt; i < 4 * 36 * 1024; i += NGT) { const int l = i / (36 * 1024), r = i % (36 * 1024), j = r >> 10, k = r & 1023;
            WR[i] = (j < 4) ? mwg[((size_t)l * 1024 + k) * 4 + j] : mwe[((size_t)l * 1024 + k) * 32 + (j - 4)]; }
        bf16_t* WBR = (bf16_t*)(ws + WS_WBRKVL);
        for (int i = gt; i < 3 * 128 * 128; i += NGT) { const int seg = i / (128 * 128), r = (i / 128) % 128, ch = i % 128; *(u32x4*)(WBR + (size_t)(3072 + seg * 256 + 128 + r) * 1024 + ch * 8) = (u32x4){0u, 0u, 0u, 0u}; }
        bf16_t* WBL2 = (bf16_t*)(ws + WS_WBL2);
        for (int i = gt; i < 5120 * 32; i += NGT) { const int r = i >> 5, ch = i & 31, k = ch * 8; int lo, hi;
            if (r < 2048) { lo = 64 * (r >> 10); hi = lo + 64; } else if (r < 4096) { lo = 128 + 64 * ((r - 2048) >> 10); hi = lo + 64; } else { lo = 0; hi = 128; }
            if (k < lo || k >= hi) *(u32x4*)(WBL2 + (size_t)r * 256 + k) = (u32x4){0u, 0u, 0u, 0u}; }
    }
    LAS float* scr = (LAS float*)(lds + 20480 + wave * 8704);
    const int gw = bx * 8 + wave, NGW = G * 8;
    for (int it = gw; it < N_SMALL_ITEMS; it += NGW) prologue_small_item(P, it, scr, lane);
    const int n_moe_here = (G == 256) ? N_MOE_PRO : N_MOE_ITEMS;
    {   const float* mw1 = P.in(I_MW1); const float* mw3 = P.in(I_MW3); const float* mw2 = P.in(I_MW2);
        MoeItem ma, mb; float ta[32], tb[32]; int lda = 0, ldb = 0;
        int it = gw;
        if (it < n_moe_here) { ma = moe_item_decode(mw1, mw3, mw2, ws, it, lane, lda); moe_item_load(ma, ta); }
        for (; it < n_moe_here; it += 2 * NGW) {
            const int itb = it + NGW, itc = it + 2 * NGW; const bool hb = itb < n_moe_here;
            if (hb) { mb = moe_item_decode(mw1, mw3, mw2, ws, itb, lane, ldb); moe_item_load(mb, tb); }
            moe_item_store(ma, lda, ta, scr, lane);
            if (itc < n_moe_here) { ma = moe_item_decode(mw1, mw3, mw2, ws, itc, lane, lda); moe_item_load(ma, ta); }
            if (hb) moe_item_store(mb, ldb, tb, scr, lane);
        }
    }
}

DI void row_load(const float* p, int lane, f32x4 (&v)[4]) {
#pragma unroll
    for (int j = 0; j < 4; ++j) v[j] = ((const f32x4*)p)[lane + 64 * j];
}
DI void row_load_x(const bf16_t* p, int lane, f32x4 (&v)[4]) {
#pragma unroll
    for (int j = 0; j < 4; ++j) { const u32x2 w = ((const u32x2*)p)[lane + 64 * j]; v[j] = (f32x4){__uint_as_float(w[0] << 16), __uint_as_float(w[0] & 0xffff0000u), __uint_as_float(w[1] << 16), __uint_as_float(w[1] & 0xffff0000u)}; }
}
DI void row_store(float* p, int lane, const f32x4 (&v)[4]) {
#pragma unroll
    for (int j = 0; j < 4; ++j) ((f32x4*)p)[lane + 64 * j] = v[j];
}
DI void row_store_bf16(bf16_t* p, int lane, const f32x4 (&v)[4]) {
#pragma unroll
    for (int j = 0; j < 4; ++j) ((u32x2*)p)[lane + 64 * j] = (u32x2){cvt_pk_bf16(v[j][0], v[j][1]), cvt_pk_bf16(v[j][2], v[j][3])};
}
DI float row_sumsq(const f32x4 (&v)[4]) {
    float s = 0.f;
#pragma unroll
    for (int j = 0; j < 4; ++j) s += (v[j][0] * v[j][0] + v[j][1] * v[j][1]) + (v[j][2] * v[j][2] + v[j][3] * v[j][3]);
    return wave_sum(s);
}
DI int moe_tables(const Ctx& P, int l, LAS unsigned char* lds, int tid);
DI void moe_combine(const Ctx& P, int lprev, int row, int lane, f32x4 (&x)[4], const LAS int* start) {
    const unsigned char* ws = P.ws;
    const int2 e_ = ((const int2*)(ws + WS_TOK))[row], p_ = ((const int2*)(ws + WS_TOK + TOK_STRIDE))[row];
    const int2 d = make_int2(start[e_.x] + p_.x, start[e_.y] + p_.y);
    const float2 w = ((const float2*)(ws + WS_TOK + 2 * TOK_STRIDE))[row];
    const bf16_t* Y = (const bf16_t*)(ws + WS_YASG);
    const float* gate = (const float*)(ws + WS_MOD) + ((size_t)(lprev * 3 + vec_of_row(row)) * 6 + 5) * 1024;
#pragma unroll
    for (int j = 0; j < 4; ++j) {
        const u32x2 y0 = ((const u32x2*)(Y + (size_t)d.x * 1024))[lane + 64 * j], y1 = ((const u32x2*)(Y + (size_t)d.y * 1024))[lane + 64 * j];
        const f32x4 g = ((const f32x4*)gate)[lane + 64 * j];
        x[j][0] += g[0] * (w.x * bf_lo(y0.x) + w.y * bf_lo(y1.x)); x[j][1] += g[1] * (w.x * bf_hi(y0.x) + w.y * bf_hi(y1.x));
        x[j][2] += g[2] * (w.x * bf_lo(y0.y) + w.y * bf_lo(y1.y)); x[j][3] += g[3] * (w.x * bf_hi(y0.y) + w.y * bf_hi(y1.y));
    }
}
DI void modulate_row(const f32x4 (&x)[4], f32x4 (&h)[4], const float* g, const float* shift, const float* scale, int lane) {
    const float rstd = rsqrtf(row_sumsq(x) * (1.0f / DM) + NORM_EPS);
#pragma unroll
    for (int j = 0; j < 4; ++j) { const f32x4 gg = ((const f32x4*)g)[lane + 64 * j], sc = ((const f32x4*)scale)[lane + 64 * j], sh = ((const f32x4*)shift)[lane + 64 * j];
        h[j] = (x[j] * rstd) * gg * (sc + 1.0f) + sh; }
}

DI void phase_norm1(const Ctx& P, int l, bool rwkv, LAS unsigned char* lds, int tid, int lane, int gw, int NGW) {
    unsigned char* ws = P.ws;
    const LAS int* start = (const LAS int*)(lds + LDS_MISC + MISC_START);
    bf16_t* XOUT = (bf16_t*)(ws + xres_of(l)); const bf16_t* XIN = (const bf16_t*)(ws + (l > 0 ? xres_of(l - 1) : WS_XRES)); const float* MOD = (const float*)(ws + WS_MOD);
    const float* xin = P.in(I_X); const float* cin = P.in(I_CTX); const float* n1g = P.in(I_N1G) + l * DM;
    if (!rwkv) {
        for (int row = gw; row < MROWS; row += 2 * NGW) {
            const bool two = row + NGW < MROWS; const int rowb = two ? row + NGW : row;
            f32x4 xa[4], xb[4], h[4];
            if (l == 0) { row_load(row < NCTXR ? cin + (size_t)row * DM : xin + (size_t)(row - NCTXR) * DM, lane, xa); row_load(rowb < NCTXR ? cin + (size_t)rowb * DM : xin + (size_t)(rowb - NCTXR) * DM, lane, xb); }
            else { row_load_x(XIN + (size_t)row * DM, lane, xa); row_load_x(XIN + (size_t)rowb * DM, lane, xb); moe_combine(P, l - 1, row, lane, xa, start); moe_combine(P, l - 1, rowb, lane, xb, start); }
            row_store_bf16(XOUT + (size_t)row * DM, lane, xa);
            { const float* m = MOD + (size_t)(l * 3 + vec_of_row(row)) * 6 * 1024; modulate_row(xa, h, n1g, m, m + 1024, lane); row_store_bf16((bf16_t*)(ws + WS_HA0) + (size_t)row * DM, lane, h); }
            if (two) { row_store_bf16(XOUT + (size_t)rowb * DM, lane, xb);
                const float* m = MOD + (size_t)(l * 3 + vec_of_row(rowb)) * 6 * 1024; modulate_row(xb, h, n1g, m, m + 1024, lane); row_store_bf16((bf16_t*)(ws + WS_HA0) + (size_t)rowb * DM, lane, h); }
        }
        return;
    }
    bf16_t* MIX = (bf16_t*)(ws + WS_MIX); const float* mu = P.in(I_BMU);
    const int wv = gw & 7, blk = gw >> 3;
    for (int b66 = blk; b66 * 66 < MROWS; b66 += NGW >> 3) {
        const int r0 = b66 * 66 + (wv < 2 ? 9 * wv : 18 + 8 * (wv - 2)), r1 = r0 + (wv < 2 ? 9 : 8);
        f32x4 hm[4], hc[4], hn[4];
#pragma unroll
        for (int j = 0; j < 4; ++j) { hm[j] = (f32x4){0.f, 0.f, 0.f, 0.f}; hc[j] = hm[j]; hn[j] = hm[j]; }
        for (int i = r0 - 1; i <= r1; ++i) {
#pragma unroll
            for (int j = 0; j < 4; ++j) { hm[j] = hc[j]; hc[j] = hn[j]; }
            if (i >= 0 && i < MROWS) { f32x4 x[4];
                row_load_x(XIN + (size_t)i * DM, lane, x); moe_combine(P, l - 1, i, lane, x, start);
                if (i >= r0 && i < r1) row_store_bf16(XOUT + (size_t)i * DM, lane, x);
                const float* m = MOD + (size_t)(l * 3 + vec_of_row(i)) * 6 * 1024;
                modulate_row(x, hn, n1g, m, m + 1024, lane);
            } else {
#pragma unroll
                for (int j = 0; j < 4; ++j) hn[j] = (f32x4){0.f, 0.f, 0.f, 0.f}; }
            const int t = i - 1;
            if (t >= r0 && t < r1) {
                int tt, T; if (t < NCTXR) { tt = t & 255; T = NCTX; } else { tt = (t - NCTXR) & 8191; T = SEQ; }
                const float wp = tt > 0 ? 0.5f : 0.0f, wn = tt < T - 1 ? 0.5f : 0.0f;
                f32x4 xx[4];
#pragma unroll
                for (int j = 0; j < 4; ++j) xx[j] = hm[j] * wp + hn[j] * wn - hc[j];
#pragma unroll
                for (int q = 0; q < 6; ++q) { f32x4 o[4];
#pragma unroll
                    for (int j = 0; j < 4; ++j) o[j] = hc[j] + xx[j] * ((const f32x4*)(mu + q * DM))[lane + 64 * j];
                    row_store_bf16(MIX + (size_t)q * ROWB + (size_t)t * DM, lane, o); }
            }
        }
    }
}
DI void phase_final(const Ctx& P, LAS unsigned char* lds, int tid, int lane, int gw, int NGW) {
    const LAS int* start = (const LAS int*)(lds + LDS_MISC + MISC_START);
    const bf16_t* XRES = (const bf16_t*)(P.ws + xres_of(DEPTH - 1)); const float* fg = P.in(I_FG); float* outp = P.out;
    for (int row = NCTXR + gw; row < MROWS; row += NGW) {
        f32x4 x[4]; row_load_x(XRES + (size_t)row * DM, lane, x); moe_combine(P, DEPTH - 1, row, lane, x, start);
        const float rstd = rsqrtf(row_sumsq(x) * (1.0f / DM) + NORM_EPS);
#pragma unroll
        for (int j = 0; j < 4; ++j) { const f32x4 gg = ((const f32x4*)fg)[lane + 64 * j]; ((f32x4*)(outp + (size_t)(row - NCTXR) * DM))[lane + 64 * j] = (x[j] * rstd) * gg; }
    }
}
DI void phase_norm2_router(const Ctx& P, int l, LAS unsigned char* lds, int tid, int lane, int gw, int NGW, bool dry = false) {
    unsigned char* ws = P.ws;
    const bf16_t* XRES = (const bf16_t*)(ws + xres_of(l)); const float* MOD = (const float*)(ws + WS_MOD);
    bf16_t* HA0 = (bf16_t*)(ws + WS_HA0);
    LAS f32x4* WRl = (LAS f32x4*)lds;
    { const f32x4* src = (const f32x4*)((const float*)(ws + WS_WR) + (size_t)l * 36 * 1024);
      for (int i = tid; i < 36 * 256; i += 512) WRl[i] = src[i]; }
    LAS int* lc = (LAS int*)(lds + LDS_MISC + 1792); LAS int* lbase = lc + 32; LAS int* rec = (LAS int*)(lds + LDS_MISC + 2048);
    if (tid < 32) lc[tid] = 0;
    __syncthreads();
    unsigned* CNT = (unsigned*)(ws + WS_CTL) + CW_CNT + l * 32 * CNT_STRIDE;
    int* LIST = (int*)(ws + WS_LIST);
    int2* TOK_E = (int2*)(ws + WS_TOK); int2* TOK_POS = (int2*)(ws + WS_TOK + TOK_STRIDE); float2* TOK_W = (float2*)(ws + WS_TOK + 2 * TOK_STRIDE);
    const int row0 = (l == DEPTH - 1) ? NCTXR : 0;
    const float* n2g = P.in(I_N2G) + l * DM; const float* mbg = P.in(I_MBG) + l * 4; const float* mbe = P.in(I_MBE) + l * 32;
    int kk_ = 0;
    for (int row = row0 + gw; row < MROWS; row += NGW, ++kk_) {
        f32x4 x[4], h[4];
        row_load_x(XRES + (size_t)row * DM, lane, x);
        if (row < NCTXR) {
            const float* part = (const float*)(ws + WS_PART) + (size_t)row * DM; const float* g1 = MOD + ((size_t)(l * 3 + 2) * 6 + 2) * 1024;
#pragma unroll
            for (int j = 0; j < 4; ++j) { f32x4 a = ((const f32x4*)part)[lane + 64 * j];
#pragma unroll
                for (int ks = 1; ks < 8; ++ks) a = a + ((const f32x4*)(part + (size_t)ks * NCTXR * DM))[lane + 64 * j];
                x[j] = x[j] + ((const f32x4*)g1)[lane + 64 * j] * a; }
            row_store_bf16((bf16_t*)(ws + xres_of(l)) + (size_t)row * DM, lane, x);
        }
        const float* m = MOD + ((size_t)(l * 3 + vec_of_row(row)) * 6 + 3) * 1024;
        modulate_row(x, h, n2g, m, m + 1024, lane);
        row_store_bf16(HA0 + (size_t)row * DM, lane, h);
        auto logit4 = [&](int g) { float pt[4];
#pragma unroll
            for (int q = 0; q < 4; ++q) { const int e = 4 * g + q; f32x4 a = h[0] * WRl[e * 256 + lane];
#pragma unroll
                for (int j = 1; j < 4; ++j) a = h[j] * WRl[e * 256 + lane + 64 * j] + a;
                pt[q] = (a[0] + a[1]) + (a[2] + a[3]); }
            float t4 = merge4_reduce16(pt[0], pt[1], pt[2], pt[3], lane);
            t4 += __shfl_xor(t4, 16); t4 += __shfl_xor(t4, 32);
            __builtin_amdgcn_sched_barrier(0); return t4; };
        const float grp0 = logit4(0);
        float lg[4];
#pragma unroll
        for (int e = 0; e < 4; ++e) lg[e] = __builtin_bit_cast(float, __builtin_amdgcn_readlane(__builtin_bit_cast(int, grp0), e)) + mbg[e];
        int gi = 0; float gm = lg[0];
#pragma unroll
        for (int e = 1; e < 4; ++e) if (lg[e] > gm) { gm = lg[e]; gi = e; }
        gi = __builtin_amdgcn_readfirstlane(gi);
        float gs = 0.f;
#pragma unroll
        for (int e = 0; e < 4; ++e) gs += __expf(lg[e] - gm);
        const float gwt = 1.0f / gs;
        const float elA = logit4(1 + 2 * gi);
        const float elB = logit4(2 + 2 * gi);
        float el[8];
#pragma unroll
        for (int k = 0; k < 4; ++k) { el[k] = __builtin_bit_cast(float, __builtin_amdgcn_readlane(__builtin_bit_cast(int, elA), k)) + mbe[8 * gi + k];
                                      el[4 + k] = __builtin_bit_cast(float, __builtin_amdgcn_readlane(__builtin_bit_cast(int, elB), k)) + mbe[8 * gi + 4 + k]; }
        int i1 = 0; float m1 = el[0];
#pragma unroll
        for (int k = 1; k < 8; ++k) if (el[k] > m1) { m1 = el[k]; i1 = k; }
        int i2 = -1; float m2 = -3.0e38f;
#pragma unroll
        for (int k = 0; k < 8; ++k) if (k != i1 && el[k] > m2) { m2 = el[k]; i2 = k; }
        const float r = __expf(m2 - m1);
        const float w1 = gwt / (1.0f + r), w2 = gwt * r / (1.0f + r);
        if (lane == 0 && !dry) {
            const int e1 = gi * 8 + i1, e2 = gi * 8 + i2;
            const int lp1 = __hip_atomic_fetch_add(&lc[e1], 1, __ATOMIC_RELAXED, __HIP_MEMORY_SCOPE_WORKGROUP), lp2 = __hip_atomic_fetch_add(&lc[e2], 1, __ATOMIC_RELAXED, __HIP_MEMORY_SCOPE_WORKGROUP);
            LAS int* r = rec + ((gw & 7) * 9 + kk_) * 6; r[0] = e1; r[1] = e2; r[2] = lp1; r[3] = lp2; r[4] = __float_as_int(w1); r[5] = __float_as_int(w2);
        }
    }
    if (!dry) {
        __syncthreads();
        if (tid < 32) { const int n = lc[tid]; lbase[tid] = n ? (int)atomicAdd(&CNT[tid * CNT_STRIDE], (unsigned)n) : 0; }
        __syncthreads();
        if (tid < 72) { const int w_ = tid / 9, k_ = tid - 9 * w_, row = row0 + (gw >> 3) * 8 + w_ + k_ * NGW;
            if (row < MROWS) { const LAS int* r = rec + tid * 6; const int e1 = r[0], e2 = r[1], p1 = lbase[e1] + r[2], p2 = lbase[e2] + r[3];
                TOK_E[row] = make_int2(e1, e2); TOK_POS[row] = make_int2(p1, p2); TOK_W[row] = make_float2(__int_as_float(r[4]), __int_as_float(r[5]));
                LIST[(size_t)e1 * MROWS + p1] = row; LIST[(size_t)e2 * MROWS + p2] = row; } }
    }
}
DI int moe_tables(const Ctx& P, int l, LAS unsigned char* lds, int tid) {
    LAS int* start = (LAS int*)(lds + LDS_MISC + MISC_START); LAS int* blk_e = (LAS int*)(lds + LDS_MISC + MISC_BLKE);
    const unsigned* CNT = (const unsigned*)(P.ws + WS_CTL) + CW_CNT + l * 32 * CNT_STRIDE;
    LAS int* cnt_l = (LAS int*)(lds + LDS_MISC + MISC_CNTL);
    __syncthreads();
    if (tid < NEXP) cnt_l[tid] = (int)__hip_atomic_load(CNT + tid * CNT_STRIDE, __ATOMIC_RELAXED, __HIP_MEMORY_SCOPE_AGENT);
    __syncthreads();
    if (tid < 64) {
        const int nb = tid < NEXP ? (cnt_l[tid & (NEXP - 1)] + 255) >> 8 : 0; int inc = nb;
#pragma unroll
        for (int o = 1; o < 32; o <<= 1) { const int v = __shfl_up(inc, o); if ((tid & 63) >= o) inc += v; }
        const int ex = inc - nb;
        if (tid < NEXP) { start[tid] = ex << 8; for (int b = 0; b < nb; ++b) blk_e[ex + b] = tid; if (tid == NEXP - 1) start[NEXP] = inc << 8; }
    }
    __syncthreads();
    return start[NEXP] >> 8;
}
template <int WGM = 8> DI bool unit_order(int i, int G, int c, int nM, int nN, int& pm, int& pn) {
    const int nwg = nM * nN, L = i * G + c; if (L >= nwg) return false;
    int w; { const int q = nwg / 8, r = nwg % 8, xcd = L % 8, off = L / 8; w = (xcd < r ? xcd * (q + 1) : r * (q + 1) + (xcd - r) * q) + off; }
    const int nig = WGM * nN, gid = w / nig, fm = gid * WGM, gsz = (nM - fm) < WGM ? (nM - fm) : WGM;
    pm = fm + ((w % nig) % gsz); pn = (w % nig) / gsz; return true;
}
struct SchedDense {
    static constexpr bool GATHER = false; static constexpr bool HALFTAIL = false;
    const char* A; const char* B; int nM, nN, G, c, pm0; size_t tileb;
    DI bool next(int i, Unit& u) const { int pm, pn; if (!unit_order(i, G, c, nM, nN, pm, pn)) return false; u.pm = pm0 + pm; u.pn = pn; u.A = A + (size_t)u.pm * tileb; u.B = B + (size_t)u.pn * tileb; return true; }
};
struct SchedCtxSplit {
    static constexpr bool GATHER = false; static constexpr bool HALFTAIL = false;
    static constexpr bool HOOKS = false;
    const char* A; const char* B; int c;
    DI bool next(int i, Unit& u) const { if (i > 0 || c >= 64) return false; const int ks = c & 7, pn = (c >> 3) & 3; u.pm = c >> 5; u.pn = pn | (ks << 2);
        u.A = A + (size_t)u.pm * (256 * 1024 * 2) + ks * 256; u.B = B + (size_t)pn * (256 * 1024 * 2) + ks * 256; return true; }
};
struct SchedRkvl {
    static constexpr bool GATHER = false; static constexpr bool HALFTAIL = false;
    const char* MIX; const char* B; int G, c;
    DI bool next(int i, Unit& u) const { if (!unit_order(i, G, c, 66, 15, u.pm, u.pn)) return false;
        const int slot = u.pn < 4 ? 0 : u.pn < 8 ? 2 : u.pn < 12 ? 3 : u.pn == 12 ? 1 : u.pn == 13 ? 4 : 5;
        u.A = MIX + (size_t)slot * ROWB * 2 + (size_t)u.pm * 256 * 1024 * 2; u.B = B + (size_t)u.pn * 256 * 1024 * 2; return true; }
};
struct SchedLora2 {
    static constexpr bool GATHER = false; static constexpr bool HALFTAIL = false;
    const char* TWA; const char* TG; const char* B; int G, c;
    DI bool next(int i, Unit& u) const { if (!unit_order(i, G, c, 66, 20, u.pm, u.pn)) return false;
        const int ko = (u.pn >= 8 && u.pn < 16) ? 256 : 0;
        u.A = (u.pn < 16 ? TWA : TG) + (size_t)u.pm * 256 * 256 * 2 + ko; u.B = B + (size_t)u.pn * 256 * 256 * 2 + ko; return true; }
};
struct SchedMoe {
    static constexpr bool GATHER = false; static constexpr bool HALFTAIL = true;
    const char* A; const char* B; int nM, nN, G, c; size_t atile, btile, bexp; const LAS int* blk_e; const LAS int* start; const LAS int* cnt;
    DI bool next(int i, Unit& u) const { if (!unit_order<2>(i, G, c, nM, nN, u.pm, u.pn)) return false;
        const int e = blk_e[u.pm]; u.half = cnt[e] - (u.pm * 256 - start[e]);
        u.A = A + (size_t)u.pm * atile; u.B = B + (size_t)e * bexp + (size_t)u.pn * btile; return true; }
};

struct SchedMoeG {
    static constexpr bool GATHER = true; static constexpr bool HALFTAIL = true;
    const char* A; const char* B; int nM, G, c; const LAS int* blk_e; const LAS int* ltok; const LAS int* start; const LAS int* cnt;
    DI bool next(int i, Unit& u) const { if (!unit_order<2>(i, G, c, nM, 6, u.pm, u.pn)) return false;
        const int e = blk_e[u.pm]; u.half = cnt[e] - (u.pm * 256 - start[e]);
        u.A = A; u.B = B + (size_t)e * ((size_t)1536 * 1024 * 2) + (size_t)u.pn * (256 * 1024 * 2); u.tok = i * 256; return true; }
    DI int tokrow(int idx) const { return ltok[idx]; }
};
constexpr int LDS_LTOK = 131072;
#define EPI_LOOP_BEGIN _Pragma("unroll") for (int ai = 0; ai < 2; ++ai) _Pragma("unroll") for (int m = 0; m < 4; ++m) { const int row = u.pm * 256 + ai * 128 + wr * 64 + m * 16 + fr;
#define EPI_LOOP_END }
DI u32x4 pack8_bf16(const f32x4& a, const f32x4& b) { return (u32x4){cvt_pk_bf16(a[0], a[1]), cvt_pk_bf16(a[2], a[3]), cvt_pk_bf16(b[0], b[1]), cvt_pk_bf16(b[2], b[3])}; }
DI h16x8 pack8_h16(const f32x4& a, const f32x4& b) { return (h16x8){(h16)a[0], (h16)a[1], (h16)a[2], (h16)a[3], (h16)b[0], (h16)b[1], (h16)b[2], (h16)b[3]}; }

DI f32x4 sigmoid4(f32x4 x) { f32x4 r; r[0] = sigmoid_f(x[0]); r[1] = sigmoid_f(x[1]); r[2] = sigmoid_f(x[2]); r[3] = sigmoid_f(x[3]); return r; }
DI float decay_e(float wl) { const float lw = -0.6065306597126334f * __builtin_amdgcn_rcpf(1.0f + __expf(-wl)); return 1.0f - __expf(lw); }
DI f32x4 decay_e4(f32x4 x) { f32x4 r; r[0] = decay_e(x[0]); r[1] = decay_e(x[1]); r[2] = decay_e(x[2]); r[3] = decay_e(x[3]); return r; }
DI float tanh_f(float x) { return 1.0f - 2.0f * __builtin_amdgcn_rcpf(__expf(2.0f * x) + 1.0f); }
struct EpiQKV {
    static constexpr bool PERM = true;
    bf16_t* Q; bf16_t* K; bf16_t* V; int dense; const float* qgain; const float* kgain; const float* RT; LAS float* xch;
    DI void operator()(const f32x4 (&acc)[2][2][4][2], const Unit& u, int wr, int wc, int fr, int fq) const {
        if (dense && u.pn == 5) {
            EPI_LOOP_BEGIN
                bf16_t* dst = V + (size_t)kvrow_of(row) * 256 + wc * 32 + 8 * fq;
#pragma unroll
                for (int bj = 0; bj < 2; ++bj) *(u32x4*)(dst + bj * 128) = pack8_bf16(acc[ai][bj][m][0], acc[ai][bj][m][1]);
            EPI_LOOP_END
            return;
        }
        const bool isQ = u.pn < 4; const int wid = wr * 4 + wc; const bool lat = u.pm >= 2; const int axis = wc & 1;
        if (dense) {
#pragma unroll
            for (int ai = 0; ai < 2; ++ai)
#pragma unroll
                for (int bj = 0; bj < 2; ++bj)
#pragma unroll
                    for (int m = 0; m < 4; ++m) { const f32x4 a = acc[ai][bj][m][0], b = acc[ai][bj][m][1];
                        float ss = (a[0] * a[0] + a[1] * a[1]) + (a[2] * a[2] + a[3] * a[3]) + (b[0] * b[0] + b[1] * b[1]) + (b[2] * b[2] + b[3] * b[3]);
                        ss += __shfl_xor(ss, 16); ss += __shfl_xor(ss, 32);
                        if (fq == 0) xch[wid * 256 + ((ai * 2 + bj) * 4 + m) * 16 + fr] = ss; }
            asm volatile("s_waitcnt lgkmcnt(0)" ::: "memory"); __builtin_amdgcn_s_barrier(); asm volatile("" ::: "memory");
        }
        const int d0 = (32 * wc + 8 * fq) & 63;
        const float scale = isQ ? C2 : 1.0f;
        f32x4 g0 = (f32x4){scale, scale, scale, scale}, g1 = g0;
        if (dense) { const float* gp = (isQ ? qgain : kgain) + d0; g0 = *(const f32x4*)gp * scale; g1 = *(const f32x4*)(gp + 4) * scale; }
        EPI_LOOP_BEGIN
            const size_t kr = (size_t)kvrow_of(row);
            const int t = (row - NCTXR) & 8191, pos = axis ? (t & 63) : (t >> 6);
            const float* rt = RT + pos * 32 + ((8 * fq) & 15) * 2;
            f32x4 c0 = (f32x4){1.f, 0.f, 1.f, 0.f}, c1 = c0, c2 = c0, c3 = c0;
            if (lat) { c0 = *(const f32x4*)rt; c1 = *(const f32x4*)(rt + 4); c2 = *(const f32x4*)(rt + 8); c3 = *(const f32x4*)(rt + 12); }
#pragma unroll
            for (int bj = 0; bj < 2; ++bj) {
                if (!dense && !isQ && bj == 1) { *(u32x4*)(V + kr * 128 + wc * 32 + 8 * fq) = pack8_bf16(acc[ai][1][m][0], acc[ai][1][m][1]); continue; }
                f32x4 a = acc[ai][bj][m][0] * g0, b = acc[ai][bj][m][1] * g1;
                if (dense) { const int xi = ((ai * 2 + bj) * 4 + m) * 16 + fr; const float rs = rsqrtf((xch[wid * 256 + xi] + xch[(wid ^ 1) * 256 + xi]) * (1.0f / 64.0f) + NORM_EPS); a = a * rs; b = b * rs; }
                if (lat) {
                    f32x4 pa, pb;
#pragma unroll
                    for (int q = 0; q < 4; ++q) { pa[q] = __shfl_xor(a[q], 32); pb[q] = __shfl_xor(b[q], 32); }
                    const float sg = fq < 2 ? -1.0f : 1.0f;
                    a[0] = a[0] * c0[0] + sg * pa[0] * c0[1]; a[1] = a[1] * c0[2] + sg * pa[1] * c0[3]; a[2] = a[2] * c1[0] + sg * pa[2] * c1[1]; a[3] = a[3] * c1[2] + sg * pa[3] * c1[3];
                    b[0] = b[0] * c2[0] + sg * pb[0] * c2[1]; b[1] = b[1] * c2[2] + sg * pb[1] * c2[3]; b[2] = b[2] * c3[0] + sg * pb[2] * c3[1]; b[3] = b[3] * c3[2] + sg * pb[3] * c3[3];
                }
                bf16_t* dst = isQ ? Q + (size_t)row * DM + u.pn * 256 : K + kr * (dense ? 256 : 128);
                *(u32x4*)(dst + bj * 128 + wc * 32 + 8 * fq) = pack8_bf16(a, b);
            }
        EPI_LOOP_END
    }
};
struct EpiResid {
    static constexpr bool PERM = true;
    bf16_t* X; const float* gate_l; float scale;
    DI void operator()(const f32x4 (&acc)[2][2][4][2], const Unit& u, int wr, int wc, int fr, int fq) const {
        const int v = u.pm < 2 ? 2 : ((u.pm - 2) >> 5);
        const float* g = gate_l + (size_t)v * 6 * 1024;
        EPI_LOOP_BEGIN
#pragma unroll
            for (int bj = 0; bj < 2; ++bj) { const int col = u.pn * 256 + bj * 128 + wc * 32 + 8 * fq; u32x4* p = (u32x4*)(X + (size_t)row * DM + col); const u32x4 w = *p;
                const f32x4 g0 = *(const f32x4*)(g + col), g1 = *(const f32x4*)(g + col + 4);
                const f32x4 x0 = (f32x4){__uint_as_float(w[0] << 16), __uint_as_float(w[0] & 0xffff0000u), __uint_as_float(w[1] << 16), __uint_as_float(w[1] & 0xffff0000u)};
                const f32x4 x1 = (f32x4){__uint_as_float(w[2] << 16), __uint_as_float(w[2] & 0xffff0000u), __uint_as_float(w[3] << 16), __uint_as_float(w[3] & 0xffff0000u)};
                *p = pack8_bf16(x0 + g0 * acc[ai][bj][m][0] * scale, x1 + g1 * acc[ai][bj][m][1] * scale); }
        EPI_LOOP_END
    }
};
struct EpiPartial {
    static constexpr bool PERM = false;
    float* PART;
    DI void operator()(const f32x4 (&acc)[2][2][4][2], const Unit& u, int wr, int wc, int fr, int fq) const {
        const int pn = u.pn & 3, ks = u.pn >> 2;
        EPI_LOOP_BEGIN
#pragma unroll
            for (int bj = 0; bj < 2; ++bj)
#pragma unroll
                for (int n = 0; n < 2; ++n) *(f32x4*)(PART + ((size_t)ks * NCTXR + row) * DM + pn * 256 + bj * 128 + wc * 32 + n * 16 + 4 * fq) = acc[ai][bj][m][n];
        EPI_LOOP_END
    }
};
struct EpiRkvl {
    static constexpr bool PERM = true;
    h16* RKV; bf16_t* TWA; bf16_t* TG;
    DI void operator()(const f32x4 (&acc)[2][2][4][2], const Unit& u, int wr, int wc, int fr, int fq) const {
        EPI_LOOP_BEGIN
            const int c8 = wc * 32 + 8 * fq;
            if (u.pn < 12) { h16* dst = RKV + (size_t)(u.pn >> 2) * ROWB + (size_t)row * DM + (u.pn & 3) * 256 + c8;
#pragma unroll
                for (int bj = 0; bj < 2; ++bj) *(h16x8*)(dst + bj * 128) = pack8_h16(acc[ai][bj][m][0], acc[ai][bj][m][1]);
            } else if (u.pn == 12) { f32x4 a = acc[ai][0][m][0], b = acc[ai][0][m][1];
#pragma unroll
                for (int q = 0; q < 4; ++q) { a[q] = tanh_f(a[q]); b[q] = tanh_f(b[q]); }
                *(u32x4*)(TWA + (size_t)row * 256 + c8) = pack8_bf16(a, b);
            } else if (u.pn == 13) { *(u32x4*)(TWA + (size_t)row * 256 + 128 + c8) = pack8_bf16(acc[ai][0][m][0], acc[ai][0][m][1]);
            } else { f32x4 a = acc[ai][0][m][0], b = acc[ai][0][m][1];
#pragma unroll
                for (int q = 0; q < 4; ++q) { a[q] = sigmoid_f(a[q]); b[q] = sigmoid_f(b[q]); }
                *(u32x4*)(TG + (size_t)row * 256 + c8) = pack8_bf16(a, b); *(u32x4*)(TG + (size_t)row * 256 + 128 + c8) = (u32x4){0x3f003f00u, 0x3f003f00u, 0x3f003f00u, 0x3f003f00u}; }
        EPI_LOOP_END
    }
};
struct EpiLora2 {
    static constexpr bool PERM = true;
    h16* EA; bf16_t* Gm; const float* w0; const float* a0;
    DI void operator()(const f32x4 (&acc)[2][2][4][2], const Unit& u, int wr, int wc, int fr, int fq) const {
        const int seg = u.pn >> 3, dir = (u.pn >> 2) & 1, colt = (u.pn & 3) * 256;
#pragma unroll
        for (int bj = 0; bj < 2; ++bj) {
            const int col = colt + bj * 128 + wc * 32 + 8 * fq;
            f32x4 wa = (f32x4){0.f, 0.f, 0.f, 0.f}, wb = wa;
            if (seg < 2) { const float* bp = (seg == 0 ? w0 : a0) + dir * 1024 + col; wa = *(const f32x4*)bp; wb = *(const f32x4*)(bp + 4); }
            h16* eo = EA + (size_t)(2 * seg + dir) * ROWB + col;
#pragma unroll
            for (int ai = 0; ai < 2; ++ai)
#pragma unroll
                for (int m = 0; m < 4; ++m) {
                    const int row = u.pm * 256 + ai * 128 + wr * 64 + m * 16 + fr;
                    f32x4 a = acc[ai][bj][m][0] + wa, b = acc[ai][bj][m][1] + wb;
                    if (seg == 0) { a = decay_e4(a); b = decay_e4(b); *(h16x8*)(eo + (size_t)row * DM) = pack8_h16(a, b); }
                    else if (seg == 1) { a = sigmoid4(a); b = sigmoid4(b); *(h16x8*)(eo + (size_t)row * DM) = pack8_h16(a, b); }
                    else *(u32x4*)(Gm + (size_t)row * DM + col) = pack8_bf16(a, b);
                    __builtin_amdgcn_sched_barrier(0);
                }
        }
    }
};
struct EpiMoe1 {
    static constexpr bool PERM = true;
    bf16_t* H;
    DI void operator()(const f32x4 (&acc)[2][2][4][2], const Unit& u, int wr, int wc, int fr, int fq) const {
        EPI_LOOP_BEGIN
            f32x4 a = acc[ai][0][m][0], b = acc[ai][0][m][1]; const f32x4 a3 = acc[ai][1][m][0], b3 = acc[ai][1][m][1];
#pragma unroll
            for (int q = 0; q < 4; ++q) { a[q] = silu_f(a[q]) * a3[q]; b[q] = silu_f(b[q]) * b3[q]; }
            *(u32x4*)(H + (size_t)row * DEXP + u.pn * 128 + wc * 32 + 8 * fq) = pack8_bf16(a, b);
        EPI_LOOP_END
    }
};
struct EpiMoe2 {
    static constexpr bool PERM = true;
    bf16_t* Y;
    DI void operator()(const f32x4 (&acc)[2][2][4][2], const Unit& u, int wr, int wc, int fr, int fq) const {
        EPI_LOOP_BEGIN
#pragma unroll
            for (int bj = 0; bj < 2; ++bj) *(u32x4*)(Y + (size_t)row * DM + u.pn * 256 + bj * 128 + wc * 32 + 8 * fq) = pack8_bf16(acc[ai][bj][m][0], acc[ai][bj][m][1]);
        EPI_LOOP_END
    }
};

DI int crow(int i, int hi) { return (i & 3) + 8 * (i >> 2) + 4 * hi; }

namespace attn_dense {
using bf16=unsigned short;
constexpr int D=64,DMQ=1024,NTILES=132;
constexpr int NW=8,QBLK=32,QB=QBLK*NW,KVBLK=64;
#define SBAR() __builtin_amdgcn_sched_barrier(0)
constexpr int NSLOT=3, SLOTB=8192;
constexpr int LDS_K=0, LDS_V=NSLOT*SLOTB, LDS_WS=2*NSLOT*SLOTB, LDS_OST=LDS_WS+NW*64*4, LDS_BYTES=LDS_OST+NW*4096;
constexpr float C2=0.125f*1.4426950408889634f;
__device__ __forceinline__ void glds16(const void*gsrc,unsigned lds_dst){unsigned keep;
  asm volatile("s_mov_b32 %0, m0\n\ts_mov_b32 m0, %2\n\ts_nop 0\n\tglobal_load_lds_dwordx4 %1, off\n\ts_mov_b32 m0, %0":"=&s"(keep):"v"(gsrc),"s"(lds_dst):"memory");}
__device__ __forceinline__ float max3f(float a,float b,float c){float r;asm("v_max3_f32 %0, %1, %2, %3":"=v"(r):"v"(a),"v"(b),"v"(c));return r;}
__device__ __forceinline__ float max2f(float a,float b){float r;asm("v_max_f32_e32 %0, %1, %2":"=v"(r):"v"(a),"v"(b));return r;}
__device__ __forceinline__ float fadd_s(float a,float b){float r;asm("v_add_f32_e32 %0, %1, %2":"=v"(r):"v"(a),"v"(b));return r;}
__device__ __forceinline__ float fsub_s(float a,float b){float r;asm("v_sub_f32_e32 %0, %1, %2":"=v"(r):"v"(a),"v"(b));return r;}
typedef float f32x2_t __attribute__((ext_vector_type(2)));
__device__ __forceinline__ unsigned cvtpk_s(float lo,float hi){f32x2_t v={lo,hi};bf16x2_t b=__builtin_convertvector(v,bf16x2_t);return __builtin_bit_cast(unsigned,b);}
#define WAIT_BAR(N) asm volatile("s_waitcnt vmcnt(" #N ") lgkmcnt(0)\n\ts_barrier":::"memory")

__device__ __forceinline__ void qkt(f32x16&p0,f32x16&p1,const char*Kslot,const bf16x8*qr,const f32x16&negm,int r32,int hi){
  const char*kb=Kslot+hi*1024+r32*16;
  #pragma unroll
  for(int d0=0;d0<4;++d0){
    const bf16x8 b0=*reinterpret_cast<const bf16x8*>(kb+d0*2048);
    const bf16x8 b1=*reinterpret_cast<const bf16x8*>(kb+d0*2048+512);
    if(d0==0){p0=__builtin_amdgcn_mfma_f32_32x32x16_bf16(b0,qr[0],negm,0,0,0);p1=__builtin_amdgcn_mfma_f32_32x32x16_bf16(b1,qr[0],negm,0,0,0);}
    else{p0=__builtin_amdgcn_mfma_f32_32x32x16_bf16(b0,qr[d0],p0,0,0,0);p1=__builtin_amdgcn_mfma_f32_32x32x16_bf16(b1,qr[d0],p1,0,0,0);}}
}
typedef __attribute__((address_space(3))) const char* lds_cptr;
typedef short v4i16_t __attribute__((ext_vector_type(4)));
__device__ __forceinline__ void kload8(bf16x8*kf,lds_cptr kp){
  kf[0]=*(const __attribute__((address_space(3))) bf16x8*)(kp);      kf[1]=*(const __attribute__((address_space(3))) bf16x8*)(kp+512);
  kf[2]=*(const __attribute__((address_space(3))) bf16x8*)(kp+2048); kf[3]=*(const __attribute__((address_space(3))) bf16x8*)(kp+2560);
  kf[4]=*(const __attribute__((address_space(3))) bf16x8*)(kp+4096); kf[5]=*(const __attribute__((address_space(3))) bf16x8*)(kp+4608);
  kf[6]=*(const __attribute__((address_space(3))) bf16x8*)(kp+6144); kf[7]=*(const __attribute__((address_space(3))) bf16x8*)(kp+6656);
}
__device__ __forceinline__ void kload2(bf16x8*kf,lds_cptr kp,int j){ kf[2*j]=*(const __attribute__((address_space(3))) bf16x8*)(kp+j*2048); kf[2*j+1]=*(const __attribute__((address_space(3))) bf16x8*)(kp+j*2048+512); }
__device__ __forceinline__ s16x4 vtr(lds_cptr p){ return __builtin_bit_cast(s16x4,__builtin_amdgcn_ds_read_tr16_b64_v4i16((__attribute__((address_space(3))) v4i16_t*)p)); }
__device__ __forceinline__ float rowmax(const f32x16&p0,const f32x16&p1){
  float a=max3f(p0[0],p0[1],p1[0]),b=max3f(p0[2],p0[3],p1[1]);a=max3f(a,p1[2],p1[3]);
  #pragma unroll
  for(int r=4;r<16;r+=4){a=max3f(a,p0[r],p0[r+1]);b=max3f(b,p0[r+2],p0[r+3]);a=max3f(a,p1[r],p1[r+1]);b=max3f(b,p1[r+2],p1[r+3]);}
  const float m=max2f(a,b);
  auto rr=__builtin_amdgcn_permlane32_swap(__float_as_uint(m),__float_as_uint(m),false,false);
  return max2f(__uint_as_float(rr[0]),__uint_as_float(rr[1]));
}
__device__ __forceinline__ void pv(f32x16*o,int vb,bf16x8 pa0,bf16x8 pa1,bf16x8 pa2,bf16x8 pa3){
  #pragma unroll
  for(int d0=0;d0<2;++d0){s16x4 lo[4],hi[4];
    #pragma unroll
    for(int ks=0;ks<4;++ks){
      asm volatile("ds_read_b64_tr_b16 %0,%1 offset:%c2":"=&v"(lo[ks]):"v"(vb),"i"(d0*4096+ks*1024):"memory");
      asm volatile("ds_read_b64_tr_b16 %0,%1 offset:%c2":"=&v"(hi[ks]):"v"(vb),"i"(d0*4096+ks*1024+512):"memory");}
    asm volatile("s_waitcnt lgkmcnt(0)":::"memory");SBAR();
    #define PK(k) (bf16x8){lo[k][0],lo[k][1],lo[k][2],lo[k][3],hi[k][0],hi[k][1],hi[k][2],hi[k][3]}
    o[d0]=__builtin_amdgcn_mfma_f32_32x32x16_bf16(pa0,PK(0),o[d0],0,0,0);
    o[d0]=__builtin_amdgcn_mfma_f32_32x32x16_bf16(pa1,PK(1),o[d0],0,0,0);
    o[d0]=__builtin_amdgcn_mfma_f32_32x32x16_bf16(pa2,PK(2),o[d0],0,0,0);
    o[d0]=__builtin_amdgcn_mfma_f32_32x32x16_bf16(pa3,PK(3),o[d0],0,0,0);
    #undef PK
  }
}

#ifndef ATTN_STORE16
#define ATTN_STORE16(p,v) (*(u32x4*)(p)=(v))
#endif
__device__ __forceinline__ void wmask(f32x16&p0,f32x16&p1,int kp0,int qpos,int hi){
  const float NEG=-INFINITY; const int kb=kp0+4*hi;
  #pragma unroll
  for(int r=0;r<16;++r){const int kv=kb+(r&3)+8*(r>>2); int d0=qpos-kv; d0=d0<0?-d0:d0; int d1=qpos-kv-32; d1=d1<0?-d1:d1; if(d0>128)p0[r]=NEG; if(d1>128)p1[r]=NEG;}
}
template<int THRL,int KVP,bool WIN> __device__ __forceinline__ void attn_unit(int qrow0,int kvrow0,int h,int kvh,const bf16*Q,const bf16*__restrict__ K,const bf16*__restrict__ V,bf16*O,char*shm,int nt_arg,int wlo,int qpos0,float sink2,const int tid){
  const int lane=tid&63,r32=lane&31,hi=lane>>5; const int wid=__builtin_amdgcn_readfirstlane(tid>>6);
  const bf16*Qw=Q+((long)qrow0+wid*QBLK)*DMQ+h*D;
  const bf16*Kh=K+(long)kvrow0*KVP+kvh*D,*Vh=V+(long)kvrow0*KVP+kvh*D;
  const unsigned lds0=(unsigned)(uintptr_t)shm;
  float*wsf=(float*)(shm+LDS_WS)+wid*64;
  const bf16*ksrc=Kh+(long)lane*KVP+wid*8;
  const bf16*vsrc=Vh+(long)(16*(wid&3)+(lane>>2))*KVP+(wid>>2)*32+(lane&3)*8;
  const unsigned kdst=lds0+LDS_K+wid*1024, vdst=lds0+LDS_V+wid*1024;
  #define TROW(t) (WIN ? ((t)<4 ? 64*(t) : 256+wlo+64*((t)-4)) : 64*(t))
  #define DMA_K(t,slot) glds16(ksrc+(long)TROW(t)*KVP,(unsigned)__builtin_amdgcn_readfirstlane(kdst+(slot)))
  #define DMA_V(t,slot) glds16(vsrc+(long)TROW(t)*KVP,(unsigned)__builtin_amdgcn_readfirstlane(vdst+(slot)))
  const int vb0=(int)(lds0+LDS_V)+((lane>>4)&1)*32+(lane&3)*8+(4*hi+((lane&15)>>2))*64;
  const char*Kbase=shm+LDS_K; bf16x8 kf[8];
  const lds_cptr shm3=(lds_cptr)shm; const lds_cptr kp0=shm3+LDS_K+hi*1024+r32*16; const lds_cptr vp0=shm3+LDS_V+((lane>>4)&1)*32+(lane&3)*8+(4*hi+((lane&15)>>2))*64;
  const int NT=nt_arg;
  const int qpos=qpos0+wid*QBLK+r32;
  DMA_K(0,0);DMA_V(0,0);DMA_K(1,SLOTB);
  bf16x8 qr[4];
  #pragma unroll
  for(int d0=0;d0<4;++d0)qr[d0]=*reinterpret_cast<const bf16x8*>(&Qw[(long)r32*DMQ+d0*16+hi*8]);
  float mhat=0.f,l_reg=0.f;f32x16 o[2];o[0]=f32x16{};o[1]=f32x16{};f32x16 negm=f32x16{};asm volatile("":"+v"(negm));
  #define CMASK(P0,P1,t) do{ if(WIN && (t)>=4) wmask(P0,P1,wlo+64*((t)-4),qpos,hi); }while(0)
  bool resc=false;
  #define START(P0,P1) do{ const float rm=rowmax(P0,P1); resc=false; \
    { const float dl=rm; mhat=fadd_s(mhat,dl); \
      _Pragma("unroll") for(int r=0;r<16;++r){P0[r]=fsub_s(P0[r],dl);P1[r]=fsub_s(P1[r],dl);} \
      _Pragma("unroll") for(int r=0;r<16;++r)negm[r]=-mhat; asm volatile("":"+v"(negm)); } \
    _Pragma("unroll") for(int r=0;r<16;++r)P0[r]=__builtin_amdgcn_exp2f(P0[r]); }while(0)
  #define RESC() do{ if(resc){ asm volatile("s_waitcnt lgkmcnt(0)":::"memory"); \
      _Pragma("unroll") for(int d_=0;d_<2;++d_) _Pragma("unroll") for(int r=0;r<16;++r)o[d_][r]*=wsf[crow(r,hi)]; } }while(0)
  f32x16 pA0,pA1,pB0,pB1;
  int sl_prev=0,sl_cur=0,sl_next=SLOTB;
  #define ROT() do{sl_prev=sl_cur;sl_cur=sl_next;sl_next=(sl_next==(NSLOT-1)*SLOTB)?0:sl_next+SLOTB;}while(0)
  DMA_K(2,2*SLOTB);
  WAIT_BAR(3);
  qkt(pA0,pA1,Kbase,qr,negm,r32,hi);asm volatile("s_nop 15\n\ts_nop 7":"+v"(pA0),"+v"(pA1));CMASK(pA0,pA1,0);
  START(pA0,pA1);
  _Pragma("unroll") for(int r=0;r<16;++r)pA1[r]=__builtin_amdgcn_exp2f(pA1[r]);
  WAIT_BAR(0);
  DMA_K(3,0);DMA_V(1,SLOTB);
  ROT();
  kload8(kf,kp0+sl_cur);
  WAIT_BAR(2);
  s16x4 vlo[8],vhi[8]; u32x4 pw0,pw1,pw2,pw3;
  #define PKW(P,B) cvtpk_s(P[B],P[B+1])
  #define PAF(k) __builtin_bit_cast(bf16x8,pw##k)
  #define VFR(i) (bf16x8){vlo[i][0],vlo[i][1],vlo[i][2],vlo[i][3],vhi[i][0],vhi[i][1],vhi[i][2],vhi[i][3]}
  #define PIN(x) asm volatile("":"+v"(x))
  #define MX3(a,b,c) __builtin_fmaxf(__builtin_fmaxf((a),(b)),(c))
  #define GAPA(MF,A0,A1,A2,A3,W0,W1,PW) do{ MF; sacc+=A0; sacc+=A1; sacc+=A2; sacc+=A3; PIN(sacc); W0; W1; PIN(PW); SBAR(); }while(0)
  #define EX(v) __builtin_amdgcn_exp2f(v)
  #define GAPB(MF,X,B) do{ MF; X[B]=EX(X[B]); X[B+1]=EX(X[B+1]); X[B+2]=EX(X[B+2]); X[B+3]=EX(X[B+3]); PIN(X); SBAR(); }while(0)
  #define VRD(i) do{ vlo[i]=vtr(vp_+(((i)>>2)*4096+((i)&3)*1024)); vhi[i]=vtr(vp_+(((i)>>2)*4096+((i)&3)*1024+512)); }while(0)
  #define KRD(G,j) do{ if(G){ kload2(kf,kp0+sl_next,j); SBAR(); } }while(0)
  #define STEP(C0,C1,P0,P1,t,GK,GV,GL) do{ SBAR(); \
    const lds_cptr vp_=vp0+sl_prev; \
    VRD(0); SBAR(); float sacc=(P0[0]+P0[1]); \
    GAPA(C0=__builtin_amdgcn_mfma_f32_32x32x16_bf16(kf[0],qr[0],negm,0,0,0), P0[2],P0[3],P0[4],P0[5],     pw0[0]=PKW(P0,0), pw0[1]=PKW(P0,2), pw0); \
    VRD(4); SBAR(); GAPA(C1=__builtin_amdgcn_mfma_f32_32x32x16_bf16(kf[1],qr[0],negm,0,0,0), P0[6],P0[7],P0[8],P0[9],     pw0[2]=PKW(P0,4), pw0[3]=PKW(P0,6), pw0); \
    VRD(1); SBAR(); GAPA(C0=__builtin_amdgcn_mfma_f32_32x32x16_bf16(kf[2],qr[1],C0,0,0,0),   P0[10],P0[11],P0[12],P0[13], pw1[0]=PKW(P0,8), pw1[1]=PKW(P0,10), pw1); \
    VRD(5); SBAR(); GAPA(C1=__builtin_amdgcn_mfma_f32_32x32x16_bf16(kf[3],qr[1],C1,0,0,0),   P0[14],P0[15],P1[0],P1[1],   pw1[2]=PKW(P0,12),pw1[3]=PKW(P0,14), pw1); \
    VRD(2); SBAR(); GAPA(C0=__builtin_amdgcn_mfma_f32_32x32x16_bf16(kf[4],qr[2],C0,0,0,0),   P1[2],P1[3],P1[4],P1[5],     pw2[0]=PKW(P1,0), pw2[1]=PKW(P1,2), pw2); \
    VRD(6); SBAR(); GAPA(C1=__builtin_amdgcn_mfma_f32_32x32x16_bf16(kf[5],qr[2],C1,0,0,0),   P1[6],P1[7],P1[8],P1[9],     pw2[2]=PKW(P1,4), pw2[3]=PKW(P1,6), pw2); \
    VRD(3); SBAR(); GAPA(C0=__builtin_amdgcn_mfma_f32_32x32x16_bf16(kf[6],qr[3],C0,0,0,0),   P1[10],P1[11],P1[12],P1[13], pw3[0]=PKW(P1,8), pw3[1]=PKW(P1,10), pw3); \
    VRD(7); SBAR(); GAPA(C1=__builtin_amdgcn_mfma_f32_32x32x16_bf16(kf[7],qr[3],C1,0,0,0),   P1[14],P1[15],0.f,0.f,       pw3[2]=PKW(P1,12),pw3[3]=PKW(P1,14), pw3); \
    l_reg+=sacc; \
    if(GK){DMA_K((t)+3,sl_cur);} if(GV){DMA_V((t)+1,sl_next);} \
    CMASK(C0,C1,t); \
    { float a=MX3(C0[0],C0[1],C1[0]),b=MX3(C0[2],C0[3],C1[1]); a=MX3(a,C1[2],C1[3]); \
      _Pragma("unroll") for(int r=4;r<16;r+=4){a=MX3(a,C0[r],C0[r+1]);b=MX3(b,C0[r+2],C0[r+3]);a=MX3(a,C1[r],C1[r+1]);b=MX3(b,C1[r+2],C1[r+3]);} \
      float rm=__builtin_fmaxf(a,b); { auto rr=__builtin_amdgcn_permlane32_swap(__float_as_uint(rm),__float_as_uint(rm),false,false); rm=__builtin_fmaxf(__uint_as_float(rr[0]),__uint_as_float(rr[1])); } \
      resc=false; \
      if(__builtin_expect(__any(rm>(float)THRL),0)){ const float dl=__builtin_fmaxf(rm,0.f); mhat+=dl; \
        _Pragma("unroll") for(int r=0;r<16;++r){C0[r]-=dl;C1[r]-=dl;} \
        _Pragma("unroll") for(int r=0;r<16;++r)negm[r]=-mhat; asm volatile("":"+v"(negm)); \
        const float f=__builtin_amdgcn_exp2f(-dl); l_reg*=f; if(hi==0)wsf[r32]=f; resc=true; } } \
    SBAR(); \
    GAPB(o[0]=__builtin_amdgcn_mfma_f32_32x32x16_bf16(PAF(0),VFR(0),o[0],0,0,0), C0,0); \
    GAPB(o[1]=__builtin_amdgcn_mfma_f32_32x32x16_bf16(PAF(0),VFR(4),o[1],0,0,0), C0,4); \
    KRD(GL,0); GAPB(o[0]=__builtin_amdgcn_mfma_f32_32x32x16_bf16(PAF(1),VFR(1),o[0],0,0,0), C0,8); \
    KRD(GL,1); GAPB(o[1]=__builtin_amdgcn_mfma_f32_32x32x16_bf16(PAF(1),VFR(5),o[1],0,0,0), C0,12); \
    KRD(GL,2); GAPB(o[0]=__builtin_amdgcn_mfma_f32_32x32x16_bf16(PAF(2),VFR(2),o[0],0,0,0), C1,0); \
    KRD(GL,3); GAPB(o[1]=__builtin_amdgcn_mfma_f32_32x32x16_bf16(PAF(2),VFR(6),o[1],0,0,0), C1,4); \
    GAPB(o[0]=__builtin_amdgcn_mfma_f32_32x32x16_bf16(PAF(3),VFR(3),o[0],0,0,0), C1,8); \
    GAPB(o[1]=__builtin_amdgcn_mfma_f32_32x32x16_bf16(PAF(3),VFR(7),o[1],0,0,0), C1,12); \
    }while(0)
  int t=1;
  #undef CMASK
  #define CMASK(P0,P1,t) do{ if(WIN && (t)>=4) wmask(P0,P1,wlo+64*((t)-4),qpos,hi); }while(0)
  for(;t+5<NT;t+=2){
    STEP(pB0,pB1,pA0,pA1,t,true,true,true);     WAIT_BAR(2); RESC(); ROT();
    STEP(pA0,pA1,pB0,pB1,t+1,true,true,true);   WAIT_BAR(2); RESC(); ROT();
  }
  #undef CMASK
  #define CMASK(P0,P1,t) do{ if(WIN && (t)>=4) wmask(P0,P1,wlo+64*((t)-4),qpos,hi); }while(0)
  #define ENDW(tt) do{ if((tt)+3<NT){WAIT_BAR(2);} else if((tt)+2<NT){WAIT_BAR(1);} else {WAIT_BAR(0);} }while(0)
  for(;t+1<NT;t+=2){
    STEP(pB0,pB1,pA0,pA1,t,(t+3<NT),(t+1<NT),(t+1<NT));       ENDW(t);   RESC(); ROT();
    STEP(pA0,pA1,pB0,pB1,t+1,(t+4<NT),(t+2<NT),(t+2<NT));     ENDW(t+1); RESC(); ROT();
  }
  STEP(pB0,pB1,pA0,pA1,NT-1,false,false,false); RESC();
  { float sacc=pB0[0]+pB0[1]; _Pragma("unroll") for(int r=2;r<16;++r)sacc+=pB0[r]; _Pragma("unroll") for(int r=0;r<16;++r)sacc+=pB1[r]; l_reg+=sacc;
    pw0=(u32x4){PKW(pB0,0),PKW(pB0,2),PKW(pB0,4),PKW(pB0,6)};pw1=(u32x4){PKW(pB0,8),PKW(pB0,10),PKW(pB0,12),PKW(pB0,14)};pw2=(u32x4){PKW(pB1,0),PKW(pB1,2),PKW(pB1,4),PKW(pB1,6)};pw3=(u32x4){PKW(pB1,8),PKW(pB1,10),PKW(pB1,12),PKW(pB1,14)};
    SBAR(); pv(o,vb0+sl_cur,PAF(0),PAF(1),PAF(2),PAF(3)); }
  #undef PKW
  #undef PAF
  #undef VFR
  #undef PIN
  #undef MX3
  #undef GAPA
  #undef GAPB
  #undef EX
  #undef VRD
  #undef KRD
  #undef STEP
  #undef ENDW
  {auto rr=__builtin_amdgcn_permlane32_swap(__float_as_uint(l_reg),__float_as_uint(l_reg),false,false);l_reg=__uint_as_float(rr[0])+__uint_as_float(rr[1]);}
  if(WIN) l_reg+=__builtin_amdgcn_exp2f(sink2-mhat);
  if(hi==0)wsf[32+r32]=l_reg;asm volatile("s_waitcnt lgkmcnt(0)":::"memory");
  float rli[16];
  #pragma unroll
  for(int r=0;r<16;++r)rli[r]=__builtin_amdgcn_rcpf(wsf[32+crow(r,hi)]);
  bf16*Ow=O+((long)qrow0+wid*QBLK)*DMQ+h*D;
  { bf16*stg=(bf16*)(shm+LDS_OST)+wid*2048;
    #pragma unroll
    for(int r=0;r<16;++r){const int orow=crow(r,hi);
      #pragma unroll
      for(int d0=0;d0<2;++d0)stg[orow*64+d0*32+r32]=(bf16)(cvtpk_s(o[d0][r]*rli[r],0.f)&0xffffu);}
    asm volatile("s_waitcnt lgkmcnt(0)":::"memory");
    #pragma unroll
    for(int i=0;i<4;++i){const int row=i*8+(lane>>3),ch=lane&7; const u32x4 v=*(const u32x4*)(stg+row*64+ch*8); ATTN_STORE16(Ow+(long)row*DMQ+ch*8,v);} }
  asm volatile("s_waitcnt lgkmcnt(0)\n\ts_barrier":::"memory");
  #undef DMA_K
  #undef TROW
  #undef DMA_V
  #undef CMASK
  #undef START
  #undef RESC
  #undef ROT
}
#undef SBAR
#undef WAIT_BAR
}

DI void phase_attention(const Ctx& P, bool dense, int j, bool with_ctx, LAS unsigned char* lds, int tid, int lane, int wave) {
    unsigned char* ws = P.ws;
    const bf16_t* Q = (const bf16_t*)(ws + WS_Q); const bf16_t* K = (const bf16_t*)(ws + WS_K); const bf16_t* V = (const bf16_t*)(ws + WS_V); bf16_t* O = (bf16_t*)(ws + WS_O);
    const int nunits = 1024 + (with_ctx ? 32 : 0);
    const float* sinkp = P.in(I_CSINK);
    const int G = gridDim.x, bx = blockIdx.x, vcu = (G % 8 == 0) ? (bx % 8) * (G / 8) + bx / 8 : bx;
    for (int u = vcu; u < nunits; u += G) {
        const bool ctxu = u >= 1024;
        const int bh = ctxu ? u - 1024 : u >> 5, qt = u & 31, b = bh >> 4, h = bh & 15, q0 = qt * 256;
        const int qrow0 = ctxu ? b * NCTX : NCTXR + b * SEQ + q0;
        if (dense) attn_dense::attn_unit<8, 256, false>(qrow0, b * KVLEN, h, h >> 2, Q, K, V, O, (char*)lds, ctxu ? 4 : KVLEN / 64, 0, 0, 0.f, tid);
        else { const int lo = q0 - 128 < 0 ? 0 : q0 - 128, hi_ = q0 + 384 > SEQ ? SEQ : q0 + 384;
            attn_dense::attn_unit<8, 128, true>(qrow0, b * KVLEN, h, h >> 3, Q, K, V, O, (char*)lds, ctxu ? 4 : 4 + (hi_ - lo) / 64, lo, q0, sinkp[h] * LOG2E, tid); }
    }
    __syncthreads();
    (void)j; (void)lane; (void)wave;
}

DI int tseq_of(int dir, bool lat, int t) { return lat ? NCTX + (dir ? (SEQ - 1 - t) : t) : (dir ? (NCTX - 1 - t) : t); }
DI void ld16h(const h16* p, float (&v)[16]) { const h16x8 a = ((const h16x8*)p)[0], b = ((const h16x8*)p)[1];
#pragma unroll
    for (int i = 0; i < 8; ++i) { v[i] = (float)a[i]; v[8 + i] = (float)b[i]; } }
DI void st16h(h16* p, const float (&v)[16]) { h16x8 a, b;
#pragma unroll
    for (int i = 0; i < 8; ++i) { a[i] = (h16)v[i]; b[i] = (h16)v[8 + i]; }
    ((h16x8*)p)[0] = a; ((h16x8*)p)[1] = b; }
constexpr int SCN_T = 32, SCN_R16 = 0, SCN_KD16 = SCN_T * 128, SCN_KK16 = 2 * SCN_T * 128, SCN_BB16 = 3 * SCN_T * 128, SCN_W32 = 4 * SCN_T * 128, SCN_V32 = SCN_W32 + SCN_T * 256, SCN_OPB = SCN_V32 + SCN_T * 16 * 4  ,
              SCN_YP0 = 2 * SCN_OPB, SCN_YPB = (SCN_T / 2) * 1024  , SCN_CONV = SCN_YP0 + 2 * SCN_YPB;
struct ScanOps { u32x2 r, kd, kk, bb; f32x4 w; float v; };
DI void scan_ld(ScanOps& o, const LAS unsigned char* base, int t, int kc, int rowl) {
    const LAS unsigned char* p = base + t * 128 + 8 * kc;
    o.r = *(const LAS u32x2*)(p + SCN_R16); o.kd = *(const LAS u32x2*)(p + SCN_KD16); o.kk = *(const LAS u32x2*)(p + SCN_KK16); o.bb = *(const LAS u32x2*)(p + SCN_BB16);
    o.w = *(const LAS f32x4*)(base + SCN_W32 + t * 256 + 16 * kc);
    (void)rowl;
}
DI int scan_row(int dir, int b, int ts) { if (ts < NCTX) return b * NCTX + (dir ? NCTX - 1 - ts : ts); const int tl = ts - NCTX; return NCTXR + b * SEQ + (dir ? SEQ - 1 - tl : tl); }
DI void phase_rwkv_scan(const Ctx& P, LAS unsigned char* lds, int tid, int lane, int wave) {
    unsigned char* ws = P.ws;
    const h16* Vm = (const h16*)(ws + WS_RKV16) + 2 * ROWB; bf16_t* YS = (bf16_t*)(ws + WS_YS);
    constexpr int NCH = KVLEN / SCN_T;
    for (int u = blockIdx.x; u < 256; u += gridDim.x) {
        const int grp = u >> 2, rq = u & 3, dir = grp >> 5, b = (grp >> 4) & 1, head = grp & 15;
        __syncthreads();
#define SCN_BAR() asm volatile("s_waitcnt lgkmcnt(0)\n\ts_barrier" ::: "memory")
        if (wave >= 4) {
            const int lt = tid - 256, st = lt >> 3, sg = lt & 7, scol = head * 64 + 8 * sg;
            const h16* Rm = (const h16*)(ws + WS_RKV16); const h16* EAm = (const h16*)(ws + WS_EA16); float* BON = (float*)(ws + WS_BONUS2);
            float ckk[8], cka[8], crk[8];
            { const float* p0 = P.in(I_BKK) + scol; const float* p1 = P.in(I_BKA) + scol; const float* p2 = P.in(I_BRK) + scol;
#pragma unroll
              for (int i = 0; i < 8; ++i) { ckk[i] = p0[i]; cka[i] = p1[i]; crk[i] = p2[i]; } }
            u32x4 preA[4], preB[4]; u32x4 prevA, prevB; int prowA = 0, prowB = 0;
#define SCN_ISSUE(S, chunk) do { prow##S = scan_row(dir, b, (chunk) * SCN_T + st); const size_t ro = (size_t)prow##S * DM + scol; \
                pre##S[0] = *(const u32x4*)(Rm + ro); pre##S[1] = *(const u32x4*)(Rm + ROWB + ro); pre##S[2] = *(const u32x4*)(EAm + (size_t)dir * ROWB + ro); pre##S[3] = *(const u32x4*)(EAm + (size_t)(2 + dir) * ROWB + ro); \
                prev##S = *(const u32x4*)(Vm + (size_t)scan_row(dir, b, (chunk) * SCN_T + ((lt & 63) >> 1)) * DM + head * 64 + rq * 16 + (lt & 1) * 8); } while (0)
#define SCN_COMMIT(S, bufp) do { LAS unsigned char* bq = (LAS unsigned char*)(bufp); LAS unsigned char* b16 = bq + st * 128 + sg * 16; \
                const h16x8 hr = __builtin_bit_cast(h16x8, pre##S[0]), hk = __builtin_bit_cast(h16x8, pre##S[1]), he = __builtin_bit_cast(h16x8, pre##S[2]), ha = __builtin_bit_cast(h16x8, pre##S[3]); \
                float kkr[8]; float n2 = 0.f; \
                _Pragma("unroll") for (int z = 0; z < 8; ++z) { kkr[z] = (float)hk[z] * ckk[z]; n2 += kkr[z] * kkr[z]; } \
                n2 = dpp_add<0xB1>(n2); n2 = dpp_add<0x4E>(n2); n2 = dpp_add<0x141>(n2); \
                const float rn = 1.0f / fmaxf(sqrtf(n2), 1e-12f); float bon = 0.f; \
                f32x4 o_w[2]; h16x8 o_kd, o_kk, o_bb; \
                _Pragma("unroll") for (int z = 0; z < 8; ++z) { const float r_ = (float)hr[z], k_ = (float)hk[z], a_ = (float)ha[z]; const float kk_ = kkr[z] * rn, kd_ = k_ * (1.0f + (a_ - 1.0f) * cka[z]); \
                    o_w[z >> 2][z & 3] = 1.0f - (float)he[z]; o_kd[z] = (h16)kd_; o_kk[z] = (h16)kk_; o_bb[z] = (h16)(-kk_ * a_); bon += r_ * kd_ * crk[z]; } \
                bon = dpp_add<0xB1>(bon); bon = dpp_add<0x4E>(bon); bon = dpp_add<0x141>(bon); \
                if (sg == 0 && rq == 0) BON[((size_t)dir * MROWS + prow##S) * 16 + head] = bon; \
                *(LAS u32x4*)(b16 + SCN_R16) = pre##S[0]; *(LAS u32x4*)(b16 + SCN_KD16) = __builtin_bit_cast(u32x4, o_kd); *(LAS u32x4*)(b16 + SCN_KK16) = __builtin_bit_cast(u32x4, o_kk); *(LAS u32x4*)(b16 + SCN_BB16) = __builtin_bit_cast(u32x4, o_bb); \
                *(LAS f32x4*)(bq + SCN_W32 + st * 256 + sg * 32) = o_w[0]; *(LAS f32x4*)(bq + SCN_W32 + st * 256 + sg * 32 + 16) = o_w[1]; \
                if (lt < 64) { const h16x8 hv = __builtin_bit_cast(h16x8, prev##S); LAS float* d = (LAS float*)(bq + SCN_V32) + (lt & 1) * 8 * SCN_T + (lt >> 1); \
                    _Pragma("unroll") for (int z = 0; z < 8; ++z) d[z * SCN_T] = (float)hv[z]; } } while (0)
#define SCN_YOUT(chunk) do { const int m_ = lt >> 4, row_ = lt & 15; \
                const LAS u32x4* yp_ = (const LAS u32x4*)(lds + SCN_YP0 + ((chunk) & 1) * SCN_YPB + m_ * 1024 + row_ * 64); \
                float ya_ = 0.f, yb_ = 0.f; \
                _Pragma("unroll") for (int q_ = 0; q_ < 4; ++q_) { const u32x4 w_ = yp_[q_]; \
                    _Pragma("unroll") for (int z_ = 0; z_ < 4; ++z_) { ya_ += __uint_as_float(w_[z_] << 16); yb_ += __uint_as_float(w_[z_] & 0xffff0000u); } } \
                const float na_ = dpp_mov<0xB1>(ya_), nb_ = dpp_mov<0xB1>(yb_);     \
                const unsigned pk_ = (row_ & 1) ? cvt_pk_bf16(nb_, yb_) : cvt_pk_bf16(ya_, na_); \
                *(unsigned*)(YS + (size_t)dir * ROWB + (size_t)scan_row(dir, b, (chunk) * SCN_T + 2 * m_ + (row_ & 1)) * DM + head * 64 + rq * 16 + (row_ & ~1)) = pk_; } while (0)
            const int glw = u * 4 + (wave - 4);
            const bool conv = (gridDim.x == 256);
            LAS float* cscr = (LAS float*)(lds + SCN_CONV + (wave - 4) * 8704);
            const float* mw1 = P.in(I_MW1); const float* mw3 = P.in(I_MW3); const float* mw2 = P.in(I_MW2);
            float tv[32]; MoeItem mi; int mldt = 0;
            static_assert((NCH & 1) == 0 && NCH > 116, "chunk schedule");
#define SCN_CVS(c) moe_item_store(mi, mldt, tv, cscr, lane)
#define SCN_CVL(c) do { mi = moe_item_decode(mw1, mw3, mw2, ws, N_MOE_PRO + glw + 1024 * (c), lane, mldt); moe_item_load(mi, tv); } while (0)
            if (conv) {
                SCN_ISSUE(A, 0); SCN_COMMIT(A, lds); SCN_ISSUE(B, 1); SCN_ISSUE(A, 2);
                mi = moe_item_decode(mw1, mw3, mw2, ws, N_MOE_PRO + glw, lane, mldt); moe_item_load(mi, tv);
                SCN_BAR();
                { SCN_CVS(0); SCN_CVL(1); SCN_COMMIT(B, lds + SCN_OPB); SCN_ISSUE(B, 3); SCN_BAR(); }
                { SCN_CVS(1); SCN_CVL(2); SCN_COMMIT(A, lds); SCN_ISSUE(A, 4); SCN_YOUT(0); SCN_BAR(); }
                for (int ch = 2; ch < 106; ch += 2) {
                    { SCN_CVS(ch); SCN_CVL(ch + 1); SCN_COMMIT(B, lds + SCN_OPB); SCN_ISSUE(B, ch + 3); SCN_YOUT(ch - 1); SCN_BAR(); }
                    { SCN_CVS(ch + 1); SCN_CVL(ch + 2); SCN_COMMIT(A, lds); SCN_ISSUE(A, ch + 4); SCN_YOUT(ch); SCN_BAR(); } }
                { SCN_CVS(106); SCN_CVL(107); SCN_COMMIT(B, lds + SCN_OPB); SCN_ISSUE(B, 109); SCN_YOUT(105); SCN_BAR(); }
                { SCN_CVS(107); SCN_COMMIT(A, lds); SCN_ISSUE(A, 110); SCN_YOUT(106); SCN_BAR(); }
                for (int ch = 108; ch < NCH - 4; ch += 2) {
                    { SCN_COMMIT(B, lds + SCN_OPB); SCN_ISSUE(B, ch + 3); SCN_YOUT(ch - 1); SCN_BAR(); }
                    { SCN_COMMIT(A, lds); SCN_ISSUE(A, ch + 4); SCN_YOUT(ch); SCN_BAR(); } }
                { SCN_COMMIT(B, lds + SCN_OPB); SCN_ISSUE(B, NCH - 1); SCN_YOUT(NCH - 5); SCN_BAR(); }
                { SCN_COMMIT(A, lds); SCN_YOUT(NCH - 4); SCN_BAR(); }
                { SCN_COMMIT(B, lds + SCN_OPB); SCN_YOUT(NCH - 3); SCN_BAR(); }
                { SCN_YOUT(NCH - 2); SCN_BAR(); }
            } else {
                SCN_ISSUE(A, 0); SCN_COMMIT(A, lds);
                SCN_BAR();
                for (int ch = 0; ch < NCH; ++ch) {
                    if (ch + 1 < NCH) { SCN_ISSUE(A, ch + 1); SCN_COMMIT(A, lds + ((ch + 1) & 1) * SCN_OPB); }
                    if (ch > 0) SCN_YOUT(ch - 1);
                    SCN_BAR(); }
            }
#undef SCN_CVS
#undef SCN_CVL
            SCN_YOUT(NCH - 1);
#undef SCN_ISSUE
#undef SCN_COMMIT
#undef SCN_YOUT
        } else {
            __builtin_amdgcn_s_setprio(3);
            const int rowl = 4 * wave + (lane >> 4), kc = lane & 15;
            f32x2 S01 = (f32x2){0.f, 0.f}, S23 = (f32x2){0.f, 0.f};
            SCN_BAR();
            for (int ch = 0; ch < NCH; ++ch) {
                const LAS unsigned char* base = lds + (ch & 1) * SCN_OPB;
                LAS unsigned char* ypb = lds + SCN_YP0 + (ch & 1) * SCN_YPB + wave * 256 + lane * 4;
                ScanOps cur, nxt, nn; scan_ld(cur, base, 0, kc, rowl); scan_ld(nxt, base, 1, kc, rowl);
                const LAS float* vrow = (const LAS float*)(base + SCN_V32) + rowl * SCN_T;
                f32x4 vq = *(const LAS f32x4*)vrow, vqn = vq;
                float ye = 0.f;
                u32x2 rp = cur.r;
#define SB_() __builtin_amdgcn_sched_barrier(0)
#pragma unroll
                for (int t = 0; t < SCN_T; ++t) {
                    if (t + 2 < SCN_T) scan_ld(nn, base, t + 2, kc, rowl);
                    if (t + 1 < SCN_T && ((t + 1) & 3) == 0) vqn = *(const LAS f32x4*)(vrow + t + 1);
                    SB_();
                    cur.v = vq[t & 3];
#define MIXL "op_sel:[0,0,0] op_sel_hi:[0,1,0]"
#define MIXH "op_sel:[0,1,0] op_sel_hi:[0,1,0]"
#define MIXL0 "op_sel:[0,0,0] op_sel_hi:[1,0,0]"
#define MIXH0 "op_sel:[1,0,0] op_sel_hi:[1,0,0]"
                    {   float dd, yo; const float vf = vq[t & 3];
                        float s0 = S01[0], s1 = S01[1], s2 = S23[0], s3 = S23[1];
                        asm volatile(
                            "v_fma_mix_f32 %[d], %[s0], %[k01], 0 " MIXL "\n\t"
                            "v_fma_mix_f32 %[yo], %[s0], %[r01], 0 " MIXL "\n\t"
                            "v_fma_mix_f32 %[d], %[s1], %[k01], %[d] " MIXH "\n\t"
                            "v_fma_mix_f32 %[yo], %[s1], %[r01], %[yo] " MIXH "\n\t"
                            "v_fma_mix_f32 %[d], %[s2], %[k23], %[d] " MIXL "\n\t"
                            "v_fma_mix_f32 %[yo], %[s2], %[r23], %[yo] " MIXL "\n\t"
                            "v_fma_mix_f32 %[d], %[s3], %[k23], %[d] " MIXH "\n\t"
                            "v_fma_mix_f32 %[yo], %[s3], %[r23], %[yo] " MIXH "\n\t"
                            "v_fma_mix_f32 v244, %[c01], %[v], 0 " MIXL0 "\n\t"
                            "v_fma_mix_f32 v245, %[c01], %[v], 0 " MIXH0 "\n\t"
                            "v_add_f32_dpp %[d], %[d], %[d] quad_perm:[1,0,3,2] row_mask:0xf bank_mask:0xf bound_ctrl:1\n\t"
                            "v_fma_mix_f32 v246, %[c23], %[v], 0 " MIXL0 "\n\t"
                            "v_fma_mix_f32 v247, %[c23], %[v], 0 " MIXH0 "\n\t"
                            "v_add_f32_dpp %[d], %[d], %[d] quad_perm:[2,3,0,1] row_mask:0xf bank_mask:0xf bound_ctrl:1\n\t"
                            "v_fmac_f32 v244, %[s0], %[w0]\n\t"
                            "v_fmac_f32 v245, %[s1], %[w1]\n\t"
                            "v_add_f32_dpp %[d], %[d], %[d] row_half_mirror row_mask:0xf bank_mask:0xf bound_ctrl:1\n\t"
                            "v_fmac_f32 v246, %[s2], %[w2]\n\t"
                            "v_fmac_f32 v247, %[s3], %[w3]\n\t"
                            "v_add_f32_dpp %[d], %[d], %[d] row_mirror row_mask:0xf bank_mask:0xf bound_ctrl:1\n\t"
                            "v_fma_mix_f32 %[s0], %[b01], %[d], v244 " MIXL0 "\n\t"
                            "v_fma_mix_f32 %[s1], %[b01], %[d], v245 " MIXH0 "\n\t"
                            "v_fma_mix_f32 %[s2], %[b23], %[d], v246 " MIXL0 "\n\t"
                            "v_fma_mix_f32 %[s3], %[b23], %[d], v247 " MIXH0
                            : [s0] "+v"(s0), [s1] "+v"(s1), [s2] "+v"(s2), [s3] "+v"(s3), [d] "=&v"(dd), [yo] "=&v"(yo)
                            : [k01] "v"(cur.kk[0]), [k23] "v"(cur.kk[1]), [r01] "v"(rp[0]), [r23] "v"(rp[1]), [c01] "v"(cur.kd[0]), [c23] "v"(cur.kd[1]),
                              [w0] "v"(cur.w[0]), [w1] "v"(cur.w[1]), [w2] "v"(cur.w[2]), [w3] "v"(cur.w[3]), [b01] "v"(cur.bb[0]), [b23] "v"(cur.bb[1]), [v] "v"(vf)
                            : "v244", "v245", "v246", "v247");
                        S01 = (f32x2){s0, s1}; S23 = (f32x2){s2, s3};
                        if (t > 0) { if (t & 1) ye = yo; else *(LAS unsigned*)(ypb + ((t - 2) >> 1) * 1024) = cvt_pk_bf16(ye, yo); }
                    }
#undef MIXL
#undef MIXH
#undef MIXL0
#undef MIXH0
                    rp = cur.r;
                    cur = nxt; nxt = nn; if (((t + 1) & 3) == 0) vq = vqn;
                    SB_();
                }
                { const h16x4 hr = __builtin_bit_cast(h16x4, rp); const float yl = (S01[0] * (float)hr[0] + S01[1] * (float)hr[1]) + (S23[0] * (float)hr[2] + S23[1] * (float)hr[3]);
                  *(LAS unsigned*)(ypb + 15 * 1024) = cvt_pk_bf16(ye, yl); }
#undef SB_
                SCN_BAR();
            }
            __builtin_amdgcn_s_setprio(0);
        }
    }
}
DI void phase_rwkv_out(const Ctx& P, int lane, int gw, int NGW) {
    unsigned char* ws = P.ws;
    const bf16_t* YS = (const bf16_t*)(ws + WS_YS); const h16* Vm = (const h16*)(ws + WS_RKV16) + 2 * ROWB; const bf16_t* Gm = (const bf16_t*)(ws + WS_G); const float* BONUS = (const float*)(ws + WS_BONUS2);
    bf16_t* HA0 = (bf16_t*)(ws + WS_HA0);
    const int c0 = 16 * lane, head = lane >> 2;
    const float* lnw = P.in(I_BLNW) + c0; const float* lnb = P.in(I_BLNB) + c0;
    for (int row = gw; row < MROWS; row += NGW) {
        float y[16], v[16];
#pragma unroll
        for (int q = 0; q < 2; ++q) { const u32x4 a = ((const u32x4*)(YS + (size_t)row * DM + c0))[q], b = ((const u32x4*)(YS + ROWB + (size_t)row * DM + c0))[q];
#pragma unroll
            for (int z = 0; z < 4; ++z) { y[8 * q + 2 * z] = bf_lo(a[z]) + bf_lo(b[z]); y[8 * q + 2 * z + 1] = bf_hi(a[z]) + bf_hi(b[z]); } }
        float s = 0.f;
#pragma unroll
        for (int i = 0; i < 16; ++i) s += y[i];
        s += __shfl_xor(s, 1); s += __shfl_xor(s, 2);
        const float mean = s * (1.0f / 64.0f);
        float q2 = 0.f;
#pragma unroll
        for (int i = 0; i < 16; ++i) { y[i] -= mean; q2 += y[i] * y[i]; }
        q2 += __shfl_xor(q2, 1); q2 += __shfl_xor(q2, 2);
        const float rstd = rsqrtf(q2 * (1.0f / 64.0f) + LN_X_EPS);
        ld16h(Vm + (size_t)row * DM + c0, v);
        const float bon = BONUS[(size_t)row * 16 + head] + BONUS[((size_t)MROWS + row) * 16 + head];
        const u32x4 g0 = ((const u32x4*)(Gm + (size_t)row * DM + c0))[0], g1 = ((const u32x4*)(Gm + (size_t)row * DM + c0))[1];
        float g[16];
        g[0] = bf_lo(g0.x); g[1] = bf_hi(g0.x); g[2] = bf_lo(g0.y); g[3] = bf_hi(g0.y); g[4] = bf_lo(g0.z); g[5] = bf_hi(g0.z); g[6] = bf_lo(g0.w); g[7] = bf_hi(g0.w);
        g[8] = bf_lo(g1.x); g[9] = bf_hi(g1.x); g[10] = bf_lo(g1.y); g[11] = bf_hi(g1.y); g[12] = bf_lo(g1.z); g[13] = bf_hi(g1.z); g[14] = bf_lo(g1.w); g[15] = bf_hi(g1.w);
        float o[16];
#pragma unroll
        for (int i = 0; i < 16; ++i) o[i] = (y[i] * rstd * lnw[i] + lnb[i] + bon * v[i]) * g[i];
        u32x4 w0, w1;
        w0.x = cvt_pk_bf16(o[0], o[1]); w0.y = cvt_pk_bf16(o[2], o[3]); w0.z = cvt_pk_bf16(o[4], o[5]); w0.w = cvt_pk_bf16(o[6], o[7]);
        w1.x = cvt_pk_bf16(o[8], o[9]); w1.y = cvt_pk_bf16(o[10], o[11]); w1.z = cvt_pk_bf16(o[12], o[13]); w1.w = cvt_pk_bf16(o[14], o[15]);
        ((u32x4*)(HA0 + (size_t)row * DM + c0))[0] = w0; ((u32x4*)(HA0 + (size_t)row * DM + c0))[1] = w1;
    }
}

#define FRESH() do { tid = threadIdx.x; asm volatile("" : "+v"(tid)); lane = tid & 63; wave = __builtin_amdgcn_readfirstlane(tid >> 6); gw = bx * 8 + wave; } while (0)
#define GRID_BAR() do { xcd_barrier_fn(bar.bar, bar.x, bar.st, tid); FRESH(); } while (0)
template <int L> DI void run_layer(const Ctx& P, LAS unsigned char* lds, const XcdBarrier& bar) {
    int tid, lane, wave, gw;
    const int G = gridDim.x, bx = blockIdx.x, NGW = G * 8;
    unsigned char* ws = P.ws;
    FRESH();

        constexpr int l = L; constexpr int kind = L % 3, j = L / 3; constexpr bool last = (L == DEPTH - 1);
        phase_norm1(P, l, kind == 1, lds, tid, lane, gw, NGW);
        GRID_BAR();
        if (kind != 1) {
            {
                const bool dense = kind == 0;
                SchedDense S; S.A = (const char*)(ws + WS_HA0); S.B = dense ? (const char*)(ws + WS_WAQKV) + (size_t)j * 1536 * 1024 * 2 : (const char*)(ws + WS_WCQKV);
                S.nN = dense ? 6 : 5; S.nM = 66; S.G = G; S.c = bx; S.pm0 = 0; S.tileb = (size_t)256 * 1024 * 2;
                EpiQKV E; E.Q = (bf16_t*)(ws + WS_Q); E.K = (bf16_t*)(ws + WS_K); E.V = (bf16_t*)(ws + WS_V); E.dense = dense ? 1 : 0;
                E.qgain = P.in(I_AQG) + j * 64; E.kgain = P.in(I_AKG) + j * 64; E.RT = (const float*)(ws + WS_ROPE); E.xch = (LAS float*)(lds + 135168);
                pg8::gemm_phase(lds, 1024, S, E, tid);
            }
            GRID_BAR();
            phase_attention(P, kind == 0, j, !last, lds, tid, lane, wave);
            GRID_BAR();
        } else {
            {   SchedRkvl S; S.MIX = (const char*)(ws + WS_MIX); S.B = (const char*)(ws + WS_WBRKVL); S.G = G; S.c = bx;
                EpiRkvl E; E.RKV = (h16*)(ws + WS_RKV16); E.TWA = (bf16_t*)(ws + WS_TWA); E.TG = (bf16_t*)(ws + WS_TG);
                pg8::gemm_phase(lds, 1024, S, E, tid);
            }
            GRID_BAR();
            {   SchedLora2 S; S.TWA = (const char*)(ws + WS_TWA); S.TG = (const char*)(ws + WS_TG); S.B = (const char*)(ws + WS_WBL2); S.G = G; S.c = bx;
                EpiLora2 E; E.EA = (h16*)(ws + WS_EA16); E.Gm = (bf16_t*)(ws + WS_G); E.w0 = P.in(I_BW0); E.a0 = P.in(I_BA0);
                int k128 = 128; asm volatile("" : "+s"(k128));
                pg8::gemm_phase(lds, k128, S, E, tid, 256);
            }
            GRID_BAR();
            phase_rwkv_scan(P, lds, tid, lane, wave);
            GRID_BAR();
            phase_rwkv_out(P, lane, gw, NGW);
            GRID_BAR();
        }
        {
            SchedDense S; S.A = kind == 1 ? (const char*)(ws + WS_HA0) : (const char*)(ws + WS_O);
            S.B = kind == 0 ? (const char*)(ws + WS_WAO) + (size_t)j * 1024 * 1024 * 2 : kind == 1 ? (const char*)(ws + WS_WBO) : (const char*)(ws + WS_WCO);
            S.nN = 4; S.pm0 = 2; S.nM = 64; S.G = G; S.c = bx; S.tileb = (size_t)256 * 1024 * 2;
            EpiResid E; E.X = (bf16_t*)(ws + xres_of(l)); E.gate_l = (const float*)(ws + WS_MOD) + (size_t)l * 3 * 6 * 1024 + 2 * 1024; E.scale = 1.0f;
            pg8::gemm_phase(lds, 1024, S, E, tid);
            if (!last) {
                SchedCtxSplit S2; S2.A = S.A; S2.B = S.B; S2.c = bx;
                EpiPartial E2; E2.PART = (float*)(ws + WS_PART);
                int k128 = 128; asm volatile("" : "+s"(k128));
                pg8::gemm_phase(lds, k128, S2, E2, tid, 1024);
            }
        }
        GRID_BAR();
        phase_norm2_router(P, l, lds, tid, lane, gw, NGW);
        GRID_BAR();
        {
        {   const int nblk = moe_tables(P, l, lds, tid);
            SchedMoeG S; S.A = (const char*)(ws + WS_HA0); S.B = (const char*)(ws + WS_WM13) + (size_t)l * 32 * 1536 * 1024 * 2; S.nM = nblk; S.G = G; S.c = bx;
            S.blk_e = (const LAS int*)(lds + LDS_MISC + MISC_BLKE); S.ltok = (const LAS int*)(lds + LDS_LTOK); S.start = (const LAS int*)(lds + LDS_MISC + MISC_START); S.cnt = (const LAS int*)(lds + LDS_MISC + MISC_CNTL);
            {
                const int* LIST = (const int*)(ws + WS_LIST); LAS int* lt_ = (LAS int*)(lds + LDS_LTOK); Unit u;
                const LAS int* start = (const LAS int*)(lds + LDS_MISC + MISC_START); const LAS int* cnt_l = (const LAS int*)(lds + LDS_MISC + MISC_CNTL);
                for (int i = 0; i < 4; ++i) { if (!S.next(i, u)) break;
                    if (tid < 256) { const int e = S.blk_e[u.pm], pos = u.pm * 256 - start[e] + tid; lt_[i * 256 + tid] = pos < cnt_l[e] ? LIST[(size_t)e * MROWS + pos] : 0; } }
                __syncthreads();
            }
            EpiMoe1 E; E.H = (bf16_t*)(ws + WS_HID);
            pg8::gemm_phase(lds, 1024, S, E, tid);
        }
        GRID_BAR();
        {   const int nblk = ((const LAS int*)(lds + LDS_MISC + MISC_START))[NEXP] >> 8;
            SchedMoe S; S.A = (const char*)(ws + WS_HID); S.B = (const char*)(ws + WS_WM2) + (size_t)l * 32 * 1024 * 768 * 2; S.nN = 4; S.nM = nblk; S.G = G; S.c = bx;
            S.atile = (size_t)256 * 768 * 2; S.btile = (size_t)256 * 768 * 2; S.bexp = (size_t)1024 * 768 * 2; S.blk_e = (const LAS int*)(lds + LDS_MISC + MISC_BLKE); S.start = (const LAS int*)(lds + LDS_MISC + MISC_START); S.cnt = (const LAS int*)(lds + LDS_MISC + MISC_CNTL);
            EpiMoe2 E; E.Y = (bf16_t*)(ws + WS_YASG);
            pg8::gemm_phase(lds, 768, S, E, tid);
        }
        GRID_BAR();
        }
    }
__global__ void __launch_bounds__(512, 2) hybrid_fwd(Params KP) {
    extern __shared__ __attribute__((aligned(16))) unsigned char lds_raw[];
    LAS unsigned char* lds = (LAS unsigned char*)lds_raw;
    int tid, lane, wave, gw;
    const int G = gridDim.x, bx = blockIdx.x, NGW = G * 8;
    FRESH();
    unsigned char* ws = KP.ws;
    for (int i = tid; i < (LDS_BYTES - LDS_MISC) / 4; i += 512) ((LAS unsigned*)(lds + LDS_MISC))[i] = 0u;
    __syncthreads();
    if (tid < N_IN) ((LAS unsigned long long*)(lds + LDS_MISC + MISC_PTAB))[tid] = (unsigned long long)KP.in[tid];
    __syncthreads();
    Ctx P; P.tab = (const volatile LAS unsigned long long*)(lds + LDS_MISC + MISC_PTAB); P.ws = ws; P.out = KP.out;
    const XcdBarrier bar = xcd_barrier_post((unsigned*)(ws + WS_CTL) + CW_BAR, (volatile LAS unsigned*)(lds + LDS_MISC + MISC_BAR));

    phase_prologue(P, lds, tid, lane, wave);
    GRID_BAR();

    run_layer<0>(P, lds, bar); run_layer<1>(P, lds, bar); run_layer<2>(P, lds, bar); run_layer<3>(P, lds, bar);
    FRESH();
    phase_final(P, lds, tid, lane, gw, NGW);
}

extern "C" void kernel_launch(void* const* d_in, const int* in_sizes, int n_in, void* d_out, int out_size, void* d_ws, size_t ws_size, hipStream_t stream) {
    static int grid = 0;
    if (grid == 0) {
        if (n_in != N_IN || out_size != NB * SEQ * DM || ws_size < WS_END) { fprintf(stderr, "kernel_launch: unexpected problem (n_in %d, out %d, ws %zu < %zu); nothing launched\n", n_in, out_size, ws_size, (size_t)WS_END); grid = -1; return; }
        int dev = 0, cus = 0, per_cu = 0;
        if (hipGetDevice(&dev) != hipSuccess || hipDeviceGetAttribute(&cus, hipDeviceAttributeMultiprocessorCount, dev) != hipSuccess) { grid = -1; return; }
        if (hipFuncSetAttribute((const void*)hybrid_fwd, hipFuncAttributeMaxDynamicSharedMemorySize, LDS_BYTES) != hipSuccess) { fprintf(stderr, "kernel_launch: hipFuncSetAttribute failed\n"); grid = -1; return; }
        if (hipOccupancyMaxActiveBlocksPerMultiprocessor(&per_cu, (const void*)hybrid_fwd, 512, LDS_BYTES) != hipSuccess || per_cu < 1) { fprintf(stderr, "kernel_launch: occupancy query says %d\n", per_cu); }
        (void)hipGetLastError();
        grid = cus;
    }
    if (grid < 0) return;
    (void)in_sizes;
    if (hipMemsetAsync((char*)d_ws + WS_CTL, 0, CTL_ZERO_BYTES, stream) != hipSuccess) { fprintf(stderr, "kernel_launch: memset failed\n"); return; }
    Params p{};
    for (int i = 0; i < N_IN; ++i) p.in[i] = (const float*)d_in[i];
    p.out = (float*)d_out; p.ws = (unsigned char*)d_ws;
    hipLaunchKernelGGL(hybrid_fwd, dim3(grid), dim3(512), LDS_BYTES, stream, p);
    const hipError_t le = hipPeekAtLastError();
    if (le != hipSuccess) fprintf(stderr, "kernel_launch: launch failed: %s\n", hipGetErrorName(le));
}
```
